# Optimizing an MI355X kernel written in HIP

```python
import jax, jax.numpy as jnp
from jax import lax
import numpy as np

D_MODEL = 2048
BATCH = 8
SEQ = 2048
DEPTH = 1

HEAD_DIM = 128
N_HEADS_SB = 8
N_HEADS_FOX = 8
D_SB = N_HEADS_SB * HEAD_DIM
D_FOX = N_HEADS_FOX * HEAD_DIM
D_FF = -(-8 * D_MODEL // (3 * 256)) * 256
Q_BLOCK = 128
RMS_EPS = 1e-6
SPLIT_SIZES = (D_SB, D_SB, D_SB, D_FOX, D_FOX, D_FOX, N_HEADS_FOX, D_MODEL, D_MODEL)
SPLIT_POINTS = (D_SB, 2 * D_SB, 3 * D_SB,
                3 * D_SB + D_FOX, 3 * D_SB + 2 * D_FOX, 3 * D_SB + 3 * D_FOX,
                3 * D_SB + 3 * D_FOX + N_HEADS_FOX,
                3 * D_SB + 3 * D_FOX + N_HEADS_FOX + D_MODEL)
D_IN = 3 * D_SB + 3 * D_FOX + N_HEADS_FOX + 2 * D_MODEL

kernel_name = "hybrid_stickbreak_forgetting_gated_block"


def rms_norm(x, g):
    xf = x.astype(jnp.float32)
    y = xf * lax.rsqrt(jnp.mean(xf * xf, axis=-1, keepdims=True) + RMS_EPS)
    return (y * g.astype(jnp.float32)).astype(x.dtype)


def split_heads(t, n_heads):
    b, s, _ = t.shape
    return t.reshape(b, s, n_heads, HEAD_DIM).transpose(0, 2, 1, 3)


def merge_heads(t):
    b, h, s, d = t.shape
    return t.transpose(0, 2, 1, 3).reshape(b, s, h * d)


def stick_breaking_block(q_blk, k, v, q_start):
    tq, tk = q_blk.shape[2], k.shape[2]
    z = jnp.einsum("bhqd,bhkd->bhqk", q_blk, k).astype(jnp.float32) * (HEAD_DIM ** -0.5)
    t_idx = q_start + jnp.arange(tq)[:, None]
    s_idx = jnp.arange(tk)[None, :]
    mask = s_idx < t_idx
    log_keep = jnp.where(mask, jax.nn.log_sigmoid(-z), 0.0)
    between = lax.cumsum(log_keep, axis=3, reverse=True) - log_keep
    w = jnp.where(mask, jnp.exp(jax.nn.log_sigmoid(z) + between), 0.0)
    return jnp.einsum("bhqk,bhkd->bhqd", w.astype(v.dtype), v)


def forgetting_block(q_blk, k, v, cum_q, cum_k, q_start):
    tq, tk = q_blk.shape[2], k.shape[2]
    logits = jnp.einsum("bhqd,bhkd->bhqk", q_blk, k).astype(jnp.float32) * (HEAD_DIM ** -0.5)
    logits = logits + cum_q[..., :, None] - cum_k[..., None, :]
    t_idx = q_start + jnp.arange(tq)[:, None]
    s_idx = jnp.arange(tk)[None, :]
    logits = jnp.where(s_idx <= t_idx, logits, -jnp.inf)
    p = jax.nn.softmax(logits, axis=-1)
    return jnp.einsum("bhqk,bhkd->bhqd", p.astype(v.dtype), v)


def token_mixer(u, w_in, b_forget, w_branch_sb, w_branch_fox, w_out):
    s = u.shape[1]
    proj = u @ w_in
    q_sb, k_sb, v_sb, q_fx, k_fx, v_fx, f_logit, g_sb, g_fx = jnp.split(proj, SPLIT_POINTS, axis=-1)
    q_sb, k_sb, v_sb = (split_heads(t, N_HEADS_SB) for t in (q_sb, k_sb, v_sb))
    q_fx, k_fx, v_fx = (split_heads(t, N_HEADS_FOX) for t in (q_fx, k_fx, v_fx))
    log_f = jax.nn.log_sigmoid((f_logit + b_forget).astype(jnp.float32))
    cum = lax.cumsum(log_f.transpose(0, 2, 1), axis=2)

    outs_sb, outs_fx = [], []
    for i in range(s // Q_BLOCK):
        q0, q1 = i * Q_BLOCK, (i + 1) * Q_BLOCK
        outs_sb.append(stick_breaking_block(q_sb[:, :, q0:q1], k_sb[:, :, :q1], v_sb[:, :, :q1], q0))
        outs_fx.append(forgetting_block(q_fx[:, :, q0:q1], k_fx[:, :, :q1], v_fx[:, :, :q1],
                                        cum[:, :, q0:q1], cum[:, :, :q1], q0))
    o_sb = merge_heads(jnp.concatenate(outs_sb, axis=2))
    o_fx = merge_heads(jnp.concatenate(outs_fx, axis=2))

    merged = jax.nn.sigmoid(g_sb) * (o_sb @ w_branch_sb) + jax.nn.sigmoid(g_fx) * (o_fx @ w_branch_fox)
    return merged @ w_out


def swiglu(u, w_gate, w_up, w_down):
    return (jax.nn.silu(u @ w_gate) * (u @ w_up)) @ w_down


def setup_inputs(seed: int = 0) -> dict:
    key = jax.random.key(seed)
    ks = jax.random.split(key, 14)
    f32 = jnp.float32

    def dense(k, fan_in, fan_out):
        return jax.random.normal(k, (DEPTH, fan_in, fan_out), f32) * (fan_in ** -0.5)

    def gain(k):
        return 1.0 + 0.02 * jax.random.normal(k, (DEPTH, D_MODEL), f32)

    return {
        "x": jax.random.normal(ks[0], (BATCH, SEQ, D_MODEL), f32),
        "norm_mix_pre": gain(ks[1]),
        "norm_mix_post": gain(ks[2]),
        "w_in": dense(ks[3], D_MODEL, D_IN),
        "b_forget": 3.0 + 0.1 * jax.random.normal(ks[4], (DEPTH, N_HEADS_FOX), f32),
        "w_branch_sb": dense(ks[5], D_SB, D_MODEL),
        "w_branch_fox": dense(ks[6], D_FOX, D_MODEL),
        "w_out": dense(ks[7], D_MODEL, D_MODEL),
        "norm_ffn_pre": gain(ks[8]),
        "norm_ffn_post": gain(ks[9]),
        "w_ffn_gate": dense(ks[10], D_MODEL, D_FF),
        "w_ffn_up": dense(ks[11], D_MODEL, D_FF),
        "w_ffn_down": dense(ks[12], D_FF, D_MODEL),
    }


def reference(x, norm_mix_pre, norm_mix_post, w_in, b_forget, w_branch_sb, w_branch_fox, w_out,
              norm_ffn_pre, norm_ffn_post, w_ffn_gate, w_ffn_up, w_ffn_down):
    h = x
    for l in range(DEPTH):
        mix = token_mixer(rms_norm(h, norm_mix_pre[l]), w_in[l], b_forget[l],
                          w_branch_sb[l], w_branch_fox[l], w_out[l])
        h = h + rms_norm(mix, norm_mix_post[l])
        ff = swiglu(rms_norm(h, norm_ffn_pre[l]), w_ffn_gate[l], w_ffn_up[l], w_ffn_down[l])
        h = h + rms_norm(ff, norm_ffn_post[l])
    return h
```

```cpp
#include <hip/hip_runtime.h>
#include <cstdio>
#include <cstdint>
namespace pg8 {
#define PG8_LAS __attribute__((address_space(3)))
typedef unsigned short bf16_t;
typedef short bf16x8 __attribute__((ext_vector_type(8)));
typedef float f32x4 __attribute__((ext_vector_type(4)));
typedef unsigned u32x4 __attribute__((ext_vector_type(4)));
constexpr int BM = 256, BK = 64, HALF = 128, HTB = HALF * BK * 2  , STAGE_BYTES = 8 * HTB, NXCD = 8, WGM = 8;

__host__ __device__ __forceinline__ int lds_byte(int r, int c) { const int st = (r >> 4) * 2 + (c >> 5), rr = r & 15, cc = c & 31, ob = rr * 64 + cc * 2; return st * 1024 + (ob ^ (((ob >> 9) & 1) << 5)); }
__host__ __device__ __forceinline__ void stage_rc(int b, int& R, int& C) { const int st = b / 1024, sb = b % 1024, swz = sb ^ (((sb >> 9) & 1) << 5); R = (st >> 1) * 16 + swz / 64; C = (st & 1) * 32 + (swz % 64) / 2; }
__host__ __device__ __forceinline__ int perm32(int rho) { const int n = rho >> 4, i = rho & 15; return 8 * (i >> 2) + 4 * n + (i & 3); }

struct Unit { int pm, pn; };
struct Gemm { const bf16_t* A; const bf16_t* Bt; int M, N, K, lda; };

struct StaticOrder {
    int nM, nN, nwg, G, c;
    __host__ __device__ void init(int M, int N, int G_, int c_) { nM = M / BM; nN = N / BM; nwg = nM * nN; G = G_; c = c_; }
    __host__ __device__ bool next(int i, Unit& u) const {
        const long L = (long)i * G + c; if (L >= nwg) return false;
        int wgid = (int)L; { const int q = nwg / NXCD, r = nwg % NXCD, xcd = wgid % NXCD, off = wgid / NXCD; wgid = (xcd < r ? xcd * (q + 1) : r * (q + 1) + (xcd - r) * q) + off; }
        const int nig = WGM * nN, gid = wgid / nig, fm = gid * WGM, gsz = (nM - fm) < WGM ? (nM - fm) : WGM;
        u.pm = fm + ((wgid % nig) % gsz); u.pn = (wgid % nig) / gsz; return true;
    }
    __device__ __forceinline__ void a_ready(const Unit&) const {}
    __device__ __forceinline__ void done(const Unit&) const {}
};
__device__ __forceinline__ unsigned cvt_pk_bf16(float lo, float hi) { unsigned r; asm volatile("v_cvt_pk_bf16_f32 %0, %1, %2" : "=v"(r) : "v"(lo), "v"(hi)); return r; }
__device__ __forceinline__ float sigmoidf_fast(float x) { return __builtin_amdgcn_rcpf(1.0f + __builtin_amdgcn_exp2f(-1.4426950408889634f * x)); }
__device__ __forceinline__ float bf_lo(unsigned w) { return __uint_as_float(w << 16); }
__device__ __forceinline__ float bf_hi(unsigned w) { return __uint_as_float(w & 0xffff0000u); }

struct EpiF32 {
    static constexpr bool PERM = false, AFTER_DRAIN = false, HAS_MID = false;
    float* C; int ldc; int kmid;
    __device__ __forceinline__ void mid(f32x4 (&)[2][2][4][2], const Unit&, int, int, int, int) const {}
    __device__ __forceinline__ void operator()(const f32x4 (&acc)[2][2][4][2], const Unit& u, int wr, int wc, int fr, int fq) const {
        const int row0 = u.pm * BM + wr * 64 + fr, col0 = u.pn * BM + wc * 32 + 4 * fq;
#pragma unroll
        for (int ai = 0; ai < 2; ++ai)
#pragma unroll
            for (int m = 0; m < 4; ++m) { float* rowp = C + (size_t)(row0 + ai * HALF + m * 16) * ldc + col0;
#pragma unroll
                for (int bj = 0; bj < 2; ++bj)
#pragma unroll
                    for (int n = 0; n < 2; ++n) *(f32x4*)(rowp + bj * HALF + n * 16) = acc[ai][bj][m][n]; }
    }
};
struct EpiProj {
    static constexpr bool PERM = true, AFTER_DRAIN = false, HAS_MID = false;
    bf16_t* QKV; bf16_t* G; int ldq, ldg, nqt, nscale; float qscale; int kmid;
    __device__ __forceinline__ void mid(f32x4 (&)[2][2][4][2], const Unit&, int, int, int, int) const {}
    __device__ __forceinline__ void operator()(const f32x4 (&acc)[2][2][4][2], const Unit& u, int wr, int wc, int fr, int fq) const {
        const int row0 = u.pm * BM + wr * 64 + fr; const bool gate = u.pn >= nqt;
        bf16_t* base = gate ? G : QKV; const int ldc = gate ? ldg : ldq; const int colt = (gate ? (u.pn - nqt) : u.pn) * BM;
        const float sc = (u.pn < nscale) ? qscale : 1.0f;
        const int col0 = colt + wc * 32 + 8 * fq;
#pragma unroll
        for (int ai = 0; ai < 2; ++ai)
#pragma unroll
            for (int m = 0; m < 4; ++m) { bf16_t* rowp = base + (size_t)(row0 + ai * HALF + m * 16) * ldc + col0;
#pragma unroll
                for (int bj = 0; bj < 2; ++bj) { f32x4 v0 = acc[ai][bj][m][0], v1 = acc[ai][bj][m][1];
                    if (gate) {
#pragma unroll
                        for (int j = 0; j < 4; ++j) { v0[j] = sigmoidf_fast(v0[j]); v1[j] = sigmoidf_fast(v1[j]); } }
                    else { v0 = v0 * sc; v1 = v1 * sc; }
                    u32x4 w; w.x = cvt_pk_bf16(v0[0], v0[1]); w.y = cvt_pk_bf16(v0[2], v0[3]); w.z = cvt_pk_bf16(v1[0], v1[1]); w.w = cvt_pk_bf16(v1[2], v1[3]);
                    *(u32x4*)(rowp + bj * HALF) = w; } }
    }
};
struct EpiBranch {
    static constexpr bool PERM = true, AFTER_DRAIN = false, HAS_MID = true;
    bf16_t* O; float* T; const bf16_t* G; int ldc, ldg, goff2; int kmid;
    __device__ __forceinline__ void mid(f32x4 (&acc)[2][2][4][2], const Unit& u, int wr, int wc, int fr, int fq) const {
        unsigned row0 = u.pm * BM + wr * 64 + fr, col0 = u.pn * BM + wc * 32 + 8 * fq;
        asm volatile("" : "+v"(row0), "+v"(col0));
        const char* Gb = (const char*)G; char* Tb = (char*)T;
#pragma unroll
        for (int ai = 0; ai < 2; ++ai)
#pragma unroll
            for (int m = 0; m < 4; ++m) { const unsigned r = row0 + ai * HALF + m * 16; const unsigned go = (r * (unsigned)ldg + col0) * 2u, to = (r * (unsigned)ldc + col0) * 4u;
#pragma unroll
                for (int bj = 0; bj < 2; ++bj) { const u32x4 g = *(const u32x4*)(Gb + (size_t)(go + bj * HALF * 2));
                    f32x4 v0 = acc[ai][bj][m][0], v1 = acc[ai][bj][m][1];
                    v0[0] *= bf_lo(g.x); v0[1] *= bf_hi(g.x); v0[2] *= bf_lo(g.y); v0[3] *= bf_hi(g.y);
                    v1[0] *= bf_lo(g.z); v1[1] *= bf_hi(g.z); v1[2] *= bf_lo(g.w); v1[3] *= bf_hi(g.w);
                    char* tp = Tb + (size_t)(to + bj * HALF * 4); *(f32x4*)tp = v0; *(f32x4*)(tp + 16) = v1;
                    acc[ai][bj][m][0] = (f32x4){0.f, 0.f, 0.f, 0.f}; acc[ai][bj][m][1] = (f32x4){0.f, 0.f, 0.f, 0.f}; }
                asm volatile("" ::: "memory"); }
    }
    __device__ __forceinline__ void operator()(const f32x4 (&acc)[2][2][4][2], const Unit& u, int wr, int wc, int fr, int fq) const {
        const unsigned row0 = u.pm * BM + wr * 64 + fr, col0 = u.pn * BM + wc * 32 + 8 * fq;
        const char* Gb = (const char*)G; const char* Tb = (const char*)T; char* Ob = (char*)O;
#pragma unroll
        for (int ai = 0; ai < 2; ++ai)
#pragma unroll
            for (int m = 0; m < 4; ++m) { const unsigned r = row0 + ai * HALF + m * 16;
                const unsigned go = (r * (unsigned)ldg + goff2 + col0) * 2u, to = (r * (unsigned)ldc + col0) * 4u, oo = (r * (unsigned)ldc + col0) * 2u;
#pragma unroll
                for (int bj = 0; bj < 2; ++bj) { const u32x4 g = *(const u32x4*)(Gb + (size_t)(go + bj * HALF * 2));
                    const char* tp = Tb + (size_t)(to + bj * HALF * 4); const f32x4 t0 = *(const f32x4*)tp, t1 = *(const f32x4*)(tp + 16);
                    f32x4 v0 = acc[ai][bj][m][0], v1 = acc[ai][bj][m][1];
                    v0[0] = t0[0] + v0[0] * bf_lo(g.x); v0[1] = t0[1] + v0[1] * bf_hi(g.x); v0[2] = t0[2] + v0[2] * bf_lo(g.y); v0[3] = t0[3] + v0[3] * bf_hi(g.y);
                    v1[0] = t1[0] + v1[0] * bf_lo(g.z); v1[1] = t1[1] + v1[1] * bf_hi(g.z); v1[2] = t1[2] + v1[2] * bf_lo(g.w); v1[3] = t1[3] + v1[3] * bf_hi(g.w);
                    u32x4 w; w.x = cvt_pk_bf16(v0[0], v0[1]); w.y = cvt_pk_bf16(v0[2], v0[3]); w.z = cvt_pk_bf16(v1[0], v1[1]); w.w = cvt_pk_bf16(v1[2], v1[3]);
                    *(u32x4*)(Ob + (size_t)(oo + bj * HALF * 2)) = w; }
                asm volatile("" ::: "memory"); }
    }
};
struct EpiSwiGLU {
    static constexpr bool PERM = true, AFTER_DRAIN = false, HAS_MID = false;
    bf16_t* O; int ldc; int kmid;
    __device__ __forceinline__ void mid(f32x4 (&)[2][2][4][2], const Unit&, int, int, int, int) const {}
    __device__ __forceinline__ void operator()(const f32x4 (&acc)[2][2][4][2], const Unit& u, int wr, int wc, int fr, int fq) const {
        const int row0 = u.pm * BM + wr * 64 + fr, col0 = u.pn * HALF + wc * 32 + 8 * fq;
#pragma unroll
        for (int ai = 0; ai < 2; ++ai)
#pragma unroll
            for (int m = 0; m < 4; ++m) { bf16_t* rowp = O + (size_t)(row0 + ai * HALF + m * 16) * ldc + col0;
                f32x4 v0, v1;
#pragma unroll
                for (int j = 0; j < 4; ++j) { const float g0 = acc[ai][0][m][0][j], g1 = acc[ai][0][m][1][j];
                    v0[j] = g0 * sigmoidf_fast(g0) * acc[ai][1][m][0][j]; v1[j] = g1 * sigmoidf_fast(g1) * acc[ai][1][m][1][j]; }
                u32x4 w; w.x = cvt_pk_bf16(v0[0], v0[1]); w.y = cvt_pk_bf16(v0[2], v0[3]); w.z = cvt_pk_bf16(v1[0], v1[1]); w.w = cvt_pk_bf16(v1[2], v1[3]);
                *(u32x4*)rowp = w; }
    }
};
template <class Epi, class Sched, bool ALIGN_EPI = false, bool SP2 = false>
__device__ __forceinline__ void gemm_phase(PG8_LAS unsigned char* lds, const Gemm g, const Sched& S, const Epi& E) {
    const int tid = threadIdx.x, wid = __builtin_amdgcn_readfirstlane(tid >> 6), lane = tid & 63, wr = wid >> 2, wc = wid & 3, fr = lane & 15, fq = lane >> 4;
    const int K = g.K, nt = K / BK;
    unsigned voffA[2], voffB[2];
#pragma unroll
    for (int i = 0; i < 2; ++i) { int R, C; stage_rc(tid * 16 + i * 8192, R, C); const int Rb = Epi::PERM ? ((R & ~31) + perm32(R & 31)) : R;
        voffA[i] = (unsigned)(R * g.lda + C) * 2u; voffB[i] = (unsigned)(Rb * K + C) * 2u; }
    const size_t kstep = (size_t)(BK * 2);
    const size_t hstepB = (size_t)HALF * K * 2, hstepA = (size_t)HALF * g.lda * 2;
    const size_t tstepA = 2 * hstepA, tstepB = 2 * hstepB;
    const unsigned ldsw = (unsigned)wid * 1024u;
    const int aoff = lds_byte(wr * 64 + fr, fq * 8), boff = lds_byte(wc * 32 + fr, fq * 8);
#define PG8_SA(b, h) (((b) * 2 + (h)) * HTB)
#define PG8_SB(b, h) ((4 + (b) * 2 + (h)) * HTB)
#define PG8_STAGE(bufoff, gbase, voff) do { _Pragma("unroll") for (int _i = 0; _i < 2; ++_i) \
        __builtin_amdgcn_global_load_lds((const unsigned*)((const char*)(gbase) + (voff)[_i]), (PG8_LAS unsigned*)(lds + (bufoff) + ldsw + _i * 8192), 16, 0, 0); } while (0)
#define PG8_LDA(dst, b, h) do { _Pragma("unroll") for (int m = 0; m < 4; ++m) _Pragma("unroll") for (int k = 0; k < 2; ++k) dst[m][k] = *(const PG8_LAS bf16x8*)(lds + PG8_SA(b, h) + aoff + m * 2048 + k * 1024); } while (0)
#define PG8_LDB(dst, b, h) do { _Pragma("unroll") for (int n = 0; n < 2; ++n) _Pragma("unroll") for (int k = 0; k < 2; ++k) dst[n][k] = *(const PG8_LAS bf16x8*)(lds + PG8_SB(b, h) + boff + n * 2048 + k * 1024); } while (0)
#define PG8_MMA(ai, bj, At, Bt) do { __builtin_amdgcn_s_setprio(1); _Pragma("unroll") for (int m = 0; m < 4; ++m) _Pragma("unroll") for (int n = 0; n < 2; ++n) _Pragma("unroll") for (int k = 0; k < 2; ++k) \
        acc[ai][bj][m][n] = __builtin_amdgcn_mfma_f32_16x16x32_bf16(Bt[n][k], At[m][k], acc[ai][bj][m][n], 0, 0, 0); __builtin_amdgcn_s_setprio(0); } while (0)
#define PG8_WAIT_V(n) asm volatile("s_waitcnt vmcnt(" #n ")" ::: "memory")
#define PG8_WAIT_L(n) asm volatile("s_waitcnt lgkmcnt(" #n ")" ::: "memory")
#define PG8_BAR __builtin_amdgcn_s_barrier()
#define PG8_SCHED __builtin_amdgcn_sched_barrier(0)
    Unit cur, nxt; int ui = 0;
    if (!S.next(0, cur)) return;
    f32x4 acc[2][2][4][2];
#pragma unroll
    for (int a = 0; a < 2; ++a)
#pragma unroll
        for (int b = 0; b < 2; ++b)
#pragma unroll
            for (int m = 0; m < 4; ++m)
#pragma unroll
                for (int n = 0; n < 2; ++n) acc[a][b][m][n] = (f32x4){0.f, 0.f, 0.f, 0.f};
    bf16x8 At[4][2], B0[2][2], B1[2][2];
    const char* cA = (const char*)g.A + (size_t)cur.pm * tstepA; const char* cB = (const char*)g.Bt + (size_t)cur.pn * tstepB;
    S.a_ready(cur);
    if constexpr (SP2) {
        PG8_STAGE(PG8_SB(0, 0), cB, voffB); PG8_STAGE(PG8_SB(0, 1), cB + hstepB, voffB); PG8_STAGE(PG8_SA(0, 0), cA, voffA); PG8_STAGE(PG8_SA(0, 1), cA + hstepA, voffA);
        if (wr == 1) PG8_BAR;
        PG8_WAIT_V(2); PG8_BAR;
        PG8_STAGE(PG8_SB(1, 0), cB + kstep, voffB); PG8_STAGE(PG8_SA(1, 0), cA + kstep, voffA); PG8_STAGE(PG8_SB(1, 1), cB + hstepB + kstep, voffB);
        PG8_WAIT_V(6); PG8_BAR;
    } else {
        PG8_STAGE(PG8_SB(0, 0), cB, voffB); PG8_STAGE(PG8_SA(0, 0), cA, voffA); PG8_STAGE(PG8_SB(0, 1), cB + hstepB, voffB); PG8_STAGE(PG8_SA(0, 1), cA + hstepA, voffA);
        if (wr == 1) PG8_BAR;
        PG8_WAIT_V(4); PG8_BAR;
        PG8_STAGE(PG8_SB(1, 0), cB + kstep, voffB); PG8_STAGE(PG8_SA(1, 0), cA + kstep, voffA); PG8_STAGE(PG8_SB(1, 1), cB + hstepB + kstep, voffB);
        PG8_WAIT_V(6); PG8_BAR;
    }
    for (;;) {
        const bool has_next = S.next(ui + 1, nxt);
        const char* nA = has_next ? (const char*)g.A + (size_t)nxt.pm * tstepA : cA; const char* nB = has_next ? (const char*)g.Bt + (size_t)nxt.pn * tstepB : cB;
        for (int t = 0; t < nt; t += 2) {
            if constexpr (Epi::HAS_MID) { if (t == E.kmid) E.mid(acc, cur, wr, wc, fr, fq); }
            const bool last = (t == nt - 2);
            const char* a1 = cA + (size_t)(t + 1) * kstep;
            const char* a2 = last ? nA : cA + (size_t)(t + 2) * kstep; const char* b2 = last ? nB : cB + (size_t)(t + 2) * kstep;
            const char* a3 = a2 + kstep; const char* b3 = b2 + kstep;
            if (last && has_next) S.a_ready(nxt);
            if constexpr (SP2) {
            PG8_LDB(B0, 0, 0); PG8_LDB(B1, 0, 1); PG8_SCHED; PG8_LDA(At, 0, 0); PG8_STAGE(PG8_SA(1, 1), a1 + hstepA, voffA);
            PG8_WAIT_V(8); PG8_WAIT_L(0); PG8_BAR; PG8_MMA(0, 0, At, B0); PG8_MMA(0, 1, At, B1); PG8_BAR; PG8_SCHED;
            PG8_LDA(At, 0, 1); PG8_STAGE(PG8_SB(0, 0), b2, voffB); PG8_STAGE(PG8_SB(0, 1), b2 + hstepB, voffB); PG8_STAGE(PG8_SA(0, 0), a2, voffA);
            PG8_WAIT_V(8); PG8_WAIT_L(0); PG8_BAR; PG8_MMA(1, 0, At, B0); PG8_MMA(1, 1, At, B1); PG8_BAR; PG8_SCHED;
            PG8_LDB(B0, 1, 0); PG8_LDB(B1, 1, 1); PG8_SCHED; PG8_LDA(At, 1, 0); PG8_STAGE(PG8_SA(0, 1), a2 + hstepA, voffA);
            PG8_WAIT_V(8); PG8_WAIT_L(0); PG8_BAR; PG8_MMA(0, 0, At, B0); PG8_MMA(0, 1, At, B1); PG8_BAR; PG8_SCHED;
            PG8_LDA(At, 1, 1); PG8_STAGE(PG8_SB(1, 0), b3, voffB); PG8_STAGE(PG8_SB(1, 1), b3 + hstepB, voffB); PG8_STAGE(PG8_SA(1, 0), a3, voffA);
            PG8_WAIT_V(8); PG8_WAIT_L(0); PG8_BAR; PG8_MMA(1, 0, At, B0); PG8_MMA(1, 1, At, B1); PG8_BAR; PG8_SCHED;
            } else {
            PG8_LDB(B0, 0, 0); PG8_SCHED; PG8_LDA(At, 0, 0); PG8_STAGE(PG8_SA(1, 1), a1 + hstepA, voffA);
            PG8_WAIT_L(8); PG8_BAR; PG8_WAIT_L(0); PG8_MMA(0, 0, At, B0); PG8_BAR; PG8_SCHED;
            PG8_LDB(B1, 0, 1); PG8_STAGE(PG8_SB(0, 0), b2, voffB);
            PG8_BAR; PG8_WAIT_L(0); PG8_MMA(0, 1, At, B1); PG8_BAR;
            PG8_LDA(At, 0, 1); PG8_STAGE(PG8_SA(0, 0), a2, voffA);
            PG8_BAR; PG8_WAIT_L(0); PG8_MMA(1, 0, At, B0); PG8_BAR; PG8_SCHED;
            PG8_STAGE(PG8_SB(0, 1), b2 + hstepB, voffB);
            PG8_WAIT_V(6); PG8_BAR; PG8_MMA(1, 1, At, B1); PG8_BAR;
            PG8_LDB(B0, 1, 0); PG8_SCHED; PG8_LDA(At, 1, 0); PG8_STAGE(PG8_SA(0, 1), a2 + hstepA, voffA);
            PG8_WAIT_L(8); PG8_BAR; PG8_WAIT_L(0); PG8_MMA(0, 0, At, B0); PG8_BAR; PG8_SCHED;
            PG8_LDB(B1, 1, 1); PG8_STAGE(PG8_SB(1, 0), b3, voffB);
            PG8_BAR; PG8_WAIT_L(0); PG8_MMA(0, 1, At, B1); PG8_BAR;
            PG8_LDA(At, 1, 1); PG8_STAGE(PG8_SA(1, 0), a3, voffA);
            PG8_BAR; PG8_WAIT_L(0); PG8_MMA(1, 0, At, B0); PG8_BAR; PG8_SCHED;
            PG8_STAGE(PG8_SB(1, 1), b3 + hstepB, voffB);
            PG8_WAIT_V(6); PG8_BAR; PG8_MMA(1, 1, At, B1); PG8_BAR;
            }
        }
        if constexpr (ALIGN_EPI) { if (wr == 0) PG8_BAR; }
        if constexpr (!Epi::AFTER_DRAIN) { E(acc, cur, wr, wc, fr, fq); S.done(cur); }
        if (!has_next) break;
#pragma unroll
        for (int a = 0; a < 2; ++a)
#pragma unroll
            for (int b = 0; b < 2; ++b)
#pragma unroll
                for (int m = 0; m < 4; ++m)
#pragma unroll
                    for (int n = 0; n < 2; ++n) acc[a][b][m][n] = (f32x4){0.f, 0.f, 0.f, 0.f};
        cur = nxt; cA = nA; cB = nB; ++ui;
        if constexpr (ALIGN_EPI) { if (wr == 1) PG8_BAR; }
    }
    PG8_WAIT_V(0);
    if constexpr (!ALIGN_EPI) { if (wr == 0) PG8_BAR; }
    PG8_BAR;
    if constexpr (Epi::AFTER_DRAIN) { E.fused(acc, cur, wr, wc, fr, fq, lds, wid, lane); S.done(cur); }
#undef PG8_SA
#undef PG8_SB
#undef PG8_STAGE
#undef PG8_LDA
#undef PG8_LDB
#undef PG8_MMA
#undef PG8_WAIT_V
#undef PG8_WAIT_L
#undef PG8_BAR
#undef PG8_SCHED
}
}
#ifndef PG8_SP2
#define PG8_SP2 true
#endif
constexpr int NWAVES = 8;
#ifndef MK_N_LAUNCHES
#define MK_N_LAUNCHES 9
#endif
constexpr int N_PHASES = 9;
constexpr int N_LAUNCHES = MK_N_LAUNCHES;
static_assert(N_LAUNCHES == 1 || N_LAUNCHES == N_PHASES, "MK_N_LAUNCHES is 1 or 9");

constexpr int BATCH = 8, SEQ = 2048, DM = 2048, NH = 8, HD = 128, DSB = 1024, DIN = 10248, FF = 5632;
constexpr int M = BATCH * SEQ;
constexpr int NPROJ = 10240;
constexpr int NQKV = 6144, NGATE = 4096, NGU = 2 * FF;
constexpr int COL_QSB = 0, COL_QFX = 1024, COL_KSB = 2048, COL_VSB = 3072, COL_KFX = 4096, COL_VFX = 5120;
constexpr float RMS_EPS = 1e-6f;
constexpr float LOG2E = 1.4426950408889634f;
constexpr float QSCALE = 0.08838834764831845f * LOG2E;

constexpr size_t MiB = 1u << 20;
constexpr size_t WS_CTL = 0, CTL_ZERO_BYTES = 1 * MiB;
constexpr size_t WS_WIN = 2 * MiB;
constexpr size_t WS_WBR = 42 * MiB;
constexpr size_t WS_WOUT = 50 * MiB;
constexpr size_t WS_WGU = 58 * MiB;
constexpr size_t WS_WDN = 102 * MiB;
constexpr size_t WS_U = 124 * MiB;
constexpr size_t WS_QKV = 188 * MiB;
constexpr size_t WS_G = 380 * MiB;
constexpr size_t WS_MIX = 188 * MiB;
constexpr size_t WS_HDN = 188 * MiB;
constexpr size_t WS_FFO = 380 * MiB;
constexpr size_t WS_LOGF = 508 * MiB;
constexpr size_t WS_CUM = 508 * MiB + 512 * 1024;
constexpr size_t WS_END = 509 * MiB;
constexpr int CW_TMO = 0, CW_CODE = 1;
constexpr int CW_BAR = 4096;

constexpr int RING_OFF = 0, RING_BYTES = 131072;
constexpr int LDSCTL_OFF = RING_BYTES, MISC_OFF = LDSCTL_OFF + 320;
constexpr int LDS_BYTES = 147456;
static_assert(MISC_OFF + 128 <= LDS_BYTES, "LDS map");
#define GAS __attribute__((address_space(1)))
#define LAS __attribute__((address_space(3)))
typedef unsigned short bf16;
typedef unsigned v4u __attribute__((ext_vector_type(4)));
typedef float f32x4 __attribute__((ext_vector_type(4)));
typedef short bf16x8 __attribute__((ext_vector_type(8)));
typedef GAS unsigned gu32;
typedef GAS unsigned long long gu64;
#define RLX_AGENT __ATOMIC_RELAXED, __HIP_MEMORY_SCOPE_AGENT
#define LDS_WAIT() asm volatile("s_waitcnt lgkmcnt(0)" ::: "memory")
#define VM_WAIT() asm volatile("s_waitcnt vmcnt(0)" ::: "memory")
__device__ __forceinline__ unsigned long long rt() { return __builtin_amdgcn_s_memrealtime(); }
__device__ __forceinline__ unsigned f2bf(float f) { unsigned u = __builtin_bit_cast(unsigned, f); return (u + 0x7fffu + ((u >> 16) & 1u)) >> 16; }
__device__ __forceinline__ unsigned pk2(float lo, float hi) { return f2bf(lo) | (f2bf(hi) << 16); }

#define XB_TMO      128
#define XB_XCNT(j)  (256  + 64 * (j))
#define XB_XSUB(j)  (1280 + 64 * (j))
#define XB_XGEN(j)  (2304 + 64 * (j))
#define XB_TOP      3328
#define XB_TOPGEN   3392
#define XCD_BAR_WORDS 3456
#define XB_SPIN_CAP (1u << 18)

__device__ __forceinline__ unsigned xb_ld(unsigned* p)              { return __hip_atomic_load(p, __ATOMIC_RELAXED, __HIP_MEMORY_SCOPE_AGENT); }
__device__ __forceinline__ unsigned xb_add(unsigned* p, unsigned v) { return __hip_atomic_fetch_add(p, v, __ATOMIC_RELAXED, __HIP_MEMORY_SCOPE_AGENT); }
__device__ __forceinline__ unsigned xb_xcc_id() { return (unsigned)__builtin_amdgcn_s_getreg((3 << 11) | 20) & 0xFu; }
#define XB_SPIN(cond, bar) do { unsigned _sp = 0; while (cond) { __builtin_amdgcn_s_sleep(1); \
    if ((++_sp & 255u) == 0u) { if (xb_ld(&(bar)[XB_TMO])) break; if (_sp > XB_SPIN_CAP) { atomicAdd(&(bar)[XB_TMO], 1u); break; } } } } while (0)

struct XcdBarrier {
    unsigned* bar; unsigned x;
    volatile LAS unsigned* st;
};

__device__ __forceinline__ XcdBarrier xcd_barrier_post(unsigned* bar, volatile LAS unsigned* st) {
    XcdBarrier b; b.bar = bar; b.x = xb_xcc_id(); b.st = st;
    if (threadIdx.x == 0) (void)xb_add(&bar[XB_XCNT(b.x)], 1u);
    return b;
}
__device__ __forceinline__ void xcd_barrier_complete(unsigned* bar, unsigned x, unsigned& nloc, unsigned& nx) {
    const unsigned G = gridDim.x * gridDim.y * gridDim.z;
    unsigned sum, cnt, mine, sp = 0u;
    for (;;) {
        sum = 0u; cnt = 0u; mine = 0u;
#pragma unroll
        for (unsigned j = 0; j < 16; ++j) { const unsigned c = xb_ld(&bar[XB_XCNT(j)]); sum += c; cnt += (c > 0u) ? 1u : 0u; mine = (j == x) ? c : mine; }
        if (sum == G) break;
        __builtin_amdgcn_s_sleep(1);
        if ((++sp & 255u) == 0u) { if (xb_ld(&bar[XB_TMO])) break; if (sp > XB_SPIN_CAP) { atomicAdd(&bar[XB_TMO], 1u); break; } }
    }
    nloc = mine > 0u ? mine : 1u; nx = cnt > 0u ? cnt : 1u;
}

__device__ __forceinline__ void xcd_barrier(const XcdBarrier& b) {
    asm volatile("s_waitcnt vmcnt(0)" ::: "memory");
    __syncthreads();
    if (threadIdx.x == 0) {
        unsigned* bar = b.bar;
        __builtin_amdgcn_s_waitcnt(0);
        unsigned nloc = b.st[0], nx = b.st[1];
        if (nloc == 0u) { xcd_barrier_complete(bar, b.x, nloc, nx); b.st[0] = nloc; b.st[1] = nx; }
        const unsigned old = xb_add(&bar[XB_XSUB(b.x)], 1u);
        const unsigned gen = old / nloc;
        if (old + 1u == (gen + 1u) * nloc) {
            __builtin_amdgcn_fence(__ATOMIC_RELEASE, "agent");
            asm volatile("s_waitcnt vmcnt(0)" ::: "memory");
            const unsigned og = xb_add(&bar[XB_TOP], 1u);
            const unsigned tg = og / nx;
            if (og + 1u == (tg + 1u) * nx) xb_add(&bar[XB_TOPGEN], 1u);
            else XB_SPIN(xb_ld(&bar[XB_TOPGEN]) == tg, bar);
            __builtin_amdgcn_fence(__ATOMIC_ACQUIRE, "agent");
            xb_add(&bar[XB_XGEN(b.x)], 1u);
            asm volatile("s_waitcnt vmcnt(0)" ::: "memory");
        } else {
            XB_SPIN(xb_ld(&bar[XB_XGEN(b.x)]) == gen, bar);
            __builtin_amdgcn_fence(__ATOMIC_ACQUIRE, "agent");
            asm volatile("s_waitcnt vmcnt(0)" ::: "memory");
        }
    }
    __syncthreads();
}
struct Frame {
    LAS unsigned char* lds;
    volatile LAS unsigned* MISC;
    gu32* ctl;
    int tid, lane, wave;
    int vcu, G;
    const float* x; float* out;
    const float *g_mix_pre, *g_mix_post, *w_in, *b_forget, *w_bsb, *w_bfx, *w_out, *g_ffn_pre, *g_ffn_post, *w_gate, *w_up, *w_down;
    bf16 *Win_t, *Wbr_t, *Wout_t, *Wgu_t, *Wdn_t;
    bf16 *U, *QKV, *GT, *HDN;
    float *MIX, *FFO, *LOGF, *CUM;
};

__device__ __forceinline__ float wave_sum(float v) {
#pragma unroll
    for (int o = 1; o < 64; o <<= 1) v += __shfl_xor(v, o);
    return v;
}
__device__ __forceinline__ void tr_item(const float* W, int Npitch, int ncol0, bf16* WT, int dpitch, int drow0, int dk0, LAS float* scr, int kb, int lane) {
    const int k0 = 64 * kb;
#pragma unroll 8
    for (int i = 0; i < 32; ++i) { const int kk = 2 * i + (lane >> 5); scr[kk * 33 + (lane & 31)] = W[(size_t)(k0 + kk) * Npitch + ncol0 + (lane & 31)]; }
    LDS_WAIT(); asm volatile("" ::: "memory");
    const int c = lane & 7;
#pragma unroll
    for (int j = 0; j < 4; ++j) { const int n = (lane >> 3) + 8 * j; const LAS float* s = scr + (8 * c) * 33 + n;
        v4u o; o.x = pk2(s[0 * 33], s[1 * 33]); o.y = pk2(s[2 * 33], s[3 * 33]); o.z = pk2(s[4 * 33], s[5 * 33]); o.w = pk2(s[6 * 33], s[7 * 33]);
        *(GAS v4u*)(WT + (size_t)(drow0 + n) * dpitch + dk0 + k0 + 8 * c) = o; }
    LDS_WAIT(); asm volatile("" ::: "memory");
}
struct Seg { const float* W; int K, Npitch, n0, ncols; bf16* WT; int dpitch, drow0, dk0, rowmode; };
__device__ __forceinline__ int seg_items(const Seg& s) { return (s.K / 64) * (s.ncols / 32); }
__device__ __forceinline__ void seg_item(const Seg& s, int item, LAS float* scr, int lane) {
    const int nblk = s.ncols / 32, kb = item / nblk, nb = item % nblk, n = 32 * nb;
    int drow = s.drow0 + n;
    if (s.rowmode) drow = 256 * (n >> 7) + (n & 127) + (s.rowmode == 2 ? 128 : 0);
    tr_item(s.W, s.Npitch, s.n0 + n, s.WT, s.dpitch, drow, s.dk0, scr, kb, lane);
}

__device__ __forceinline__ void p0_prologue(Frame& F) {
    LAS float* scr = (LAS float*)(F.lds + RING_OFF + F.wave * 16384);
    const int gw = F.vcu * NWAVES + F.wave, NGW = F.G * NWAVES;
    {
        const Seg segs[11] = {
            {F.w_in, DM, DIN, 0, 1024, F.Win_t, DM, 0, 0, 0},
            {F.w_in, DM, DIN, 1024, 2048, F.Win_t, DM, 2048, 0, 0},
            {F.w_in, DM, DIN, 3072, 1024, F.Win_t, DM, 1024, 0, 0},
            {F.w_in, DM, DIN, 4096, 2048, F.Win_t, DM, 4096, 0, 0},
            {F.w_in, DM, DIN, 6152, 4096, F.Win_t, DM, 6144, 0, 0},
            {F.w_bsb, DSB, DM, 0, DM, F.Wbr_t, 2 * DSB, 0, 0, 0},
            {F.w_bfx, DSB, DM, 0, DM, F.Wbr_t, 2 * DSB, 0, DSB, 0},
            {F.w_out, DM, DM, 0, DM, F.Wout_t, DM, 0, 0, 0},
            {F.w_gate, DM, FF, 0, FF, F.Wgu_t, DM, 0, 0, 1},
            {F.w_up, DM, FF, 0, FF, F.Wgu_t, DM, 0, 0, 2},
            {F.w_down, FF, DM, 0, DM, F.Wdn_t, FF, 0, 0, 0},
        };
        int base = 0;
#pragma unroll
        for (int si = 0; si < 11; ++si) {
            const int ni = seg_items(segs[si]);
            int first = (gw - (base % NGW) + NGW) % NGW;
            for (int it = first; it < ni; it += NGW) seg_item(segs[si], it, scr, F.lane);
            base += ni;
        }
    }
    __syncthreads();
    LAS float* Wf = (LAS float*)(F.lds + RING_OFF);
    for (int k = F.tid; k < DM; k += NWAVES * 64) {
        const float g = F.g_mix_pre[k];
        const f32x4 a = *(const GAS f32x4*)(F.w_in + (size_t)k * DIN + 6144), b = *(const GAS f32x4*)(F.w_in + (size_t)k * DIN + 6148);
        Wf[0 * DM + k] = g * a.x; Wf[1 * DM + k] = g * a.y; Wf[2 * DM + k] = g * a.z; Wf[3 * DM + k] = g * a.w;
        Wf[4 * DM + k] = g * b.x; Wf[5 * DM + k] = g * b.y; Wf[6 * DM + k] = g * b.z; Wf[7 * DM + k] = g * b.w;
    }
    __syncthreads();
    const float bfh = F.b_forget[F.lane & 7];
    for (int m = gw; m < M; m += NGW) {
        const GAS f32x4* xr = (const GAS f32x4*)(F.x + (size_t)m * DM) + F.lane;
        f32x4 v[8]; float s = 0.f;
#pragma unroll
        for (int j = 0; j < 8; ++j) { v[j] = xr[64 * j]; s += (v[j].x * v[j].x + v[j].y * v[j].y) + (v[j].z * v[j].z + v[j].w * v[j].w); }
        const float rstd = 1.0f / sqrtf(wave_sum(s) * (1.f / DM) + RMS_EPS);
        float mine = 0.f;
#pragma unroll 1
        for (int h = 0; h < 8; ++h) { float a = 0.f;
#pragma unroll
            for (int j = 0; j < 8; ++j) { const f32x4 w = *(const LAS f32x4*)(Wf + h * DM + 256 * j + 4 * F.lane); a += (v[j].x * w.x + v[j].y * w.y) + (v[j].z * w.z + v[j].w * w.w); }
            const float t = wave_sum(a); if ((F.lane & 7) == h) mine = t; }
        GAS unsigned long long* o8 = (GAS unsigned long long*)(F.U + (size_t)m * DM) + F.lane;
#pragma unroll
        for (int j = 0; j < 8; ++j) { const f32x4 gj = ((const GAS f32x4*)F.g_mix_pre)[64 * j + F.lane]; const f32x4 u = v[j] * rstd * gj;
            o8[64 * j] = (unsigned long long)pk2(u.x, u.y) | ((unsigned long long)pk2(u.z, u.w) << 32); }
        if (F.lane < 8) { const float y = mine * rstd + bfh;
            F.LOGF[(size_t)m * 8 + F.lane] = -(fmaxf(-y, 0.f) + log1pf(expf(-fabsf(y)))); }
    }
}

__device__ __forceinline__ void cumsum_step(Frame& F) {
    if (F.vcu < BATCH * NH) {
        const int bh = F.vcu, b = bh / NH, h = bh % NH;
        LAS float* part = (LAS float*)(F.lds + RING_OFF);
        float v[4]; float run = 0.f;
#pragma unroll
        for (int i = 0; i < 4; ++i) { run += F.LOGF[(size_t)(b * SEQ + 4 * F.tid + i) * 8 + h]; v[i] = run; }
        float inc = run;
#pragma unroll
        for (int o = 1; o < 64; o <<= 1) { const float t = __shfl_up(inc, o); if (F.lane >= o) inc += t; }
        if (F.lane == 63) part[F.wave] = inc;
        __syncthreads();
        float woff = 0.f;
        for (int w = 0; w < F.wave; ++w) woff += part[w];
        const float off = woff + inc - run;
#pragma unroll
        for (int i = 0; i < 4; ++i) F.CUM[(size_t)bh * SEQ + 4 * F.tid + i] = off + v[i];
    }
    __syncthreads();
}

__device__ __forceinline__ void unpack8(const v4u w, float* f) {
    f[0] = __uint_as_float(w.x << 16); f[1] = __uint_as_float(w.x & 0xffff0000u); f[2] = __uint_as_float(w.y << 16); f[3] = __uint_as_float(w.y & 0xffff0000u);
    f[4] = __uint_as_float(w.z << 16); f[5] = __uint_as_float(w.z & 0xffff0000u); f[6] = __uint_as_float(w.w << 16); f[7] = __uint_as_float(w.w & 0xffff0000u);
}
__device__ __forceinline__ void naive_attn_item(Frame& F, int br, int b, int h, int qb) {
    LAS bf16* Ks = (LAS bf16*)(F.lds + RING_OFF); LAS bf16* Vs = Ks + 64 * HD;
    const int row = F.tid >> 2, part = F.tid & 3, t = qb * 128 + row;
    const size_t grow = (size_t)(b * SEQ + t);
    const bf16* qp = F.QKV + grow * NQKV + (br ? COL_QFX : COL_QSB) + h * HD + part * 32;
    float q[32], o[32];
#pragma unroll
    for (int c = 0; c < 4; ++c) { unpack8(*(const GAS v4u*)(qp + 8 * c), q + 8 * c); }
#pragma unroll
    for (int i = 0; i < 32; ++i) o[i] = 0.f;
    const int kcol = (br ? COL_KFX : COL_KSB) + h * HD, vcol = (br ? COL_VFX : COL_VSB) + h * HD;
    const float* cum = F.CUM + (size_t)(b * NH + h) * SEQ;
    const float cq = br ? cum[t] * LOG2E : 0.f;
    float mrun = -1e30f, lrun = 0.f, carry = 0.f;
    const int NT = (qb * 128 + 128) / 64;
    for (int it = 0; it < NT; ++it) {
        const int jt = br ? it : NT - 1 - it;
        __syncthreads();
#pragma unroll
        for (int i = 0; i < 2; ++i) { const int idx = F.tid + 512 * i, r = idx >> 4, c = (idx & 15) * 8; const size_t gr = (size_t)(b * SEQ + jt * 64 + r) * NQKV;
            *(LAS v4u*)(Ks + r * HD + c) = *(const GAS v4u*)(F.QKV + gr + kcol + c); *(LAS v4u*)(Vs + r * HD + c) = *(const GAS v4u*)(F.QKV + gr + vcol + c); }
        __syncthreads();
        for (int kk = 0; kk < 64; ++kk) {
            const int si = br ? kk : 63 - kk, s = jt * 64 + si;
            float d = 0.f; float kf[8];
#pragma unroll
            for (int c = 0; c < 4; ++c) { unpack8(*(const LAS v4u*)(Ks + si * HD + part * 32 + 8 * c), kf);
#pragma unroll
                for (int e = 0; e < 8; ++e) d += q[8 * c + e] * kf[e]; }
            d += __shfl_xor(d, 1); d += __shfl_xor(d, 2);
            float wgt = 0.f, alpha = 1.f;
            if (br) {
                if (s <= t) { const float logit = d + cq - cum[s] * LOG2E; const float mn = fmaxf(mrun, logit);
                    alpha = exp2f(mrun - mn); wgt = exp2f(logit - mn); lrun = lrun * alpha + wgt; mrun = mn; }
            } else {
                if (s < t) { const float e = exp2f(-fabsf(d)); const float l2 = log2f(1.0f + e); const float sp = fmaxf(d, 0.f) + l2;
                    wgt = exp2f((d - sp) - carry); carry += sp; }
            }
#pragma unroll
            for (int c = 0; c < 4; ++c) { unpack8(*(const LAS v4u*)(Vs + si * HD + part * 32 + 8 * c), kf);
#pragma unroll
                for (int e = 0; e < 8; ++e) o[8 * c + e] = o[8 * c + e] * alpha + wgt * kf[e]; }
        }
    }
    const float inv = br ? 1.0f / lrun : 1.0f;
    bf16* op = F.QKV + grow * NQKV + (br ? 1024 : 0) + h * HD + part * 32;
#pragma unroll
    for (int c = 0; c < 4; ++c) { v4u w; w.x = pk2(o[8 * c] * inv, o[8 * c + 1] * inv); w.y = pk2(o[8 * c + 2] * inv, o[8 * c + 3] * inv);
        w.z = pk2(o[8 * c + 4] * inv, o[8 * c + 5] * inv); w.w = pk2(o[8 * c + 6] * inv, o[8 * c + 7] * inv); *(GAS v4u*)(op + 8 * c) = w; }
}
__device__ __forceinline__ void naive_attn_phase(Frame& F) {
    for (int i = blockIdx.x; i < 16 * 128; i += F.G) { const int qb = i >> 7, br = (i >> 6) & 1, bh = i & 63; naive_attn_item(F, br, bh / NH, bh % NH, qb); }
    __syncthreads();
}

__device__ __forceinline__ void p5_rows(Frame& F) {
    const int gw = F.vcu * NWAVES + F.wave, NGW = F.G * NWAVES;
    for (int m = gw; m < M; m += NGW) {
        const GAS f32x4* mr = (const GAS f32x4*)(F.MIX + (size_t)m * DM) + F.lane;
        const GAS f32x4* xr = (const GAS f32x4*)(F.x + (size_t)m * DM) + F.lane;
        f32x4 v[8], xv[8]; float s = 0.f;
#pragma unroll
        for (int j = 0; j < 8; ++j) { v[j] = mr[64 * j]; xv[j] = xr[64 * j]; s += (v[j].x * v[j].x + v[j].y * v[j].y) + (v[j].z * v[j].z + v[j].w * v[j].w); }
        const float rstd = 1.0f / sqrtf(wave_sum(s) * (1.f / DM) + RMS_EPS);
        float s2 = 0.f;
        GAS f32x4* orow = (GAS f32x4*)(F.out + (size_t)m * DM) + F.lane;
#pragma unroll
        for (int j = 0; j < 8; ++j) { const f32x4 g = ((const GAS f32x4*)F.g_mix_post)[64 * j + F.lane]; const f32x4 hh = xv[j] + v[j] * rstd * g; v[j] = hh; orow[64 * j] = hh;
            s2 += (hh.x * hh.x + hh.y * hh.y) + (hh.z * hh.z + hh.w * hh.w); }
        const float rstd2 = 1.0f / sqrtf(wave_sum(s2) * (1.f / DM) + RMS_EPS);
        GAS unsigned long long* o8 = (GAS unsigned long long*)(F.U + (size_t)m * DM) + F.lane;
#pragma unroll
        for (int j = 0; j < 8; ++j) { const f32x4 g = ((const GAS f32x4*)F.g_ffn_pre)[64 * j + F.lane]; const f32x4 u = v[j] * rstd2 * g;
            o8[64 * j] = (unsigned long long)pk2(u.x, u.y) | ((unsigned long long)pk2(u.z, u.w) << 32); }
    }
}
__device__ __forceinline__ void p8_rows(Frame& F) {
    const int gw = F.vcu * NWAVES + F.wave, NGW = F.G * NWAVES;
    for (int m = gw; m < M; m += NGW) {
        const GAS f32x4* fr = (const GAS f32x4*)(F.FFO + (size_t)m * DM) + F.lane;
        GAS f32x4* orow = (GAS f32x4*)(F.out + (size_t)m * DM) + F.lane;
        f32x4 v[8], hv[8]; float s = 0.f;
#pragma unroll
        for (int j = 0; j < 8; ++j) { v[j] = fr[64 * j]; hv[j] = orow[64 * j]; s += (v[j].x * v[j].x + v[j].y * v[j].y) + (v[j].z * v[j].z + v[j].w * v[j].w); }
        const float rstd = 1.0f / sqrtf(wave_sum(s) * (1.f / DM) + RMS_EPS);
#pragma unroll
        for (int j = 0; j < 8; ++j) { const f32x4 g = ((const GAS f32x4*)F.g_ffn_post)[64 * j + F.lane]; orow[64 * j] = hv[j] + v[j] * rstd * g; }
    }
}

struct Args { const float* in[13]; float* out; unsigned char* ws; int ph_lo, ph_hi; };
__global__ void __launch_bounds__(NWAVES * 64, 2) layer_fwd(Args args) {
    extern __shared__ __attribute__((aligned(16))) unsigned char lds[];
    Frame F;
    F.lds = (LAS unsigned char*)lds;
    F.MISC = (volatile LAS unsigned*)(F.lds + MISC_OFF);
    F.tid = threadIdx.x; F.lane = F.tid & 63; F.wave = __builtin_amdgcn_readfirstlane(F.tid >> 6);
    F.G = gridDim.x; { const int bx = blockIdx.x; F.vcu = (F.G % 8 == 0) ? (bx % 8) * (F.G / 8) + bx / 8 : bx; }
    unsigned char* ws = args.ws;
    F.ctl = (gu32*)(ws + WS_CTL);
    F.x = args.in[0]; F.g_mix_pre = args.in[1]; F.g_mix_post = args.in[2]; F.w_in = args.in[3]; F.b_forget = args.in[4]; F.w_bsb = args.in[5]; F.w_bfx = args.in[6];
    F.w_out = args.in[7]; F.g_ffn_pre = args.in[8]; F.g_ffn_post = args.in[9]; F.w_gate = args.in[10]; F.w_up = args.in[11]; F.w_down = args.in[12]; F.out = args.out;
    F.Win_t = (bf16*)(ws + WS_WIN); F.Wbr_t = (bf16*)(ws + WS_WBR); F.Wout_t = (bf16*)(ws + WS_WOUT); F.Wgu_t = (bf16*)(ws + WS_WGU); F.Wdn_t = (bf16*)(ws + WS_WDN);
    F.U = (bf16*)(ws + WS_U); F.QKV = (bf16*)(ws + WS_QKV); F.GT = (bf16*)(ws + WS_G); F.HDN = (bf16*)(ws + WS_HDN);
    F.MIX = (float*)(ws + WS_MIX); F.FFO = (float*)(ws + WS_FFO); F.LOGF = (float*)(ws + WS_LOGF); F.CUM = (float*)(ws + WS_CUM);
    for (int u = F.tid; u < (LDS_BYTES - LDSCTL_OFF) / 4; u += NWAVES * 64) ((LAS unsigned*)(F.lds + LDSCTL_OFF))[u] = 0u;
    __syncthreads();
    XcdBarrier bar; bar.bar = (unsigned*)(F.ctl + CW_BAR); bar.x = 0; bar.st = nullptr;
    if (N_LAUNCHES == 1) bar = xcd_barrier_post((unsigned*)(F.ctl + CW_BAR), F.MISC + 8);
#define GRID_BAR() do { if (N_LAUNCHES == 1) xcd_barrier(bar); } while (0)
    const int lo = args.ph_lo, hi = args.ph_hi;
#ifndef PH_MASK
#define PH_MASK 0x1ff
#endif
#define IN(k) (((PH_MASK >> (k)) & 1) && lo <= (k) && (k) < hi)
#define BOTH(k) (IN(k) && IN((k) + 1))

    if (IN(0)) { p0_prologue(F); if (BOTH(0)) GRID_BAR(); }
    if (IN(1)) {
        cumsum_step(F);
        pg8::Gemm g{F.U, F.Win_t, M, NPROJ, DM, DM}; pg8::StaticOrder S; S.init(M, NPROJ, F.G, (int)blockIdx.x);
        pg8::EpiProj E{F.QKV, F.GT, NQKV, NGATE, NQKV / 256, 2048 / 256, QSCALE, 0};
        pg8::gemm_phase<pg8::EpiProj, pg8::StaticOrder, true, true>(F.lds + RING_OFF, g, S, E);
        if (BOTH(1)) GRID_BAR();
    }
    if (IN(2)) { naive_attn_phase(F); if (BOTH(2)) GRID_BAR(); }
    if (IN(3)) {
        pg8::Gemm g{F.QKV, F.Wbr_t, M, DM, 2 * DSB, NQKV}; pg8::StaticOrder S; S.init(M, DM, F.G, (int)blockIdx.x);
        pg8::EpiBranch E{F.U, F.out, F.GT, DM, NGATE, DM, DSB / 64};
        pg8::gemm_phase<pg8::EpiBranch, pg8::StaticOrder, true, true>(F.lds + RING_OFF, g, S, E);
        if (BOTH(3)) GRID_BAR();
    }
    if (IN(4)) {
        pg8::Gemm g{F.U, F.Wout_t, M, DM, DM, DM}; pg8::StaticOrder S; S.init(M, DM, F.G, (int)blockIdx.x);
        pg8::EpiF32 E{F.MIX, DM, 0};
        pg8::gemm_phase<pg8::EpiF32, pg8::StaticOrder, true, true>(F.lds + RING_OFF, g, S, E);
        if (BOTH(4)) GRID_BAR();
    }
    if (IN(5)) { p5_rows(F); if (BOTH(5)) GRID_BAR(); }
    if (IN(6)) {
        pg8::Gemm g{F.U, F.Wgu_t, M, NGU, DM, DM}; pg8::StaticOrder S; S.init(M, NGU, F.G, (int)blockIdx.x);
        pg8::EpiSwiGLU E{F.HDN, FF, 0};
        pg8::gemm_phase<pg8::EpiSwiGLU, pg8::StaticOrder, true, true>(F.lds + RING_OFF, g, S, E);
        if (BOTH(6)) GRID_BAR();
    }
    if (IN(7)) {
        pg8::Gemm g{F.HDN, F.Wdn_t, M, DM, FF, FF}; pg8::StaticOrder S; S.init(M, DM, F.G, (int)blockIdx.x);
        pg8::EpiF32 E{F.FFO, DM, 0};
        pg8::gemm_phase<pg8::EpiF32, pg8::StaticOrder, true, true>(F.lds + RING_OFF, g, S, E);
        if (BOTH(7)) GRID_BAR();
    }
    if (IN(8)) { p8_rows(F); }
#undef IN
#undef BOTH
}

extern "C" void kernel_launch(void* const* d_in, const int* in_sizes, int n_in, void* d_out, int out_size, void* d_ws, size_t ws_size, hipStream_t stream) {
    static int grid = 0;
    if (grid == 0) {
        if (n_in != 13 || in_sizes[0] != M * DM || out_size != M * DM || ws_size < WS_END) {
            fprintf(stderr, "kernel_launch: unexpected shapes (n_in %d, in0 %d, out %d, ws %zu); nothing launched\n", n_in, n_in > 0 ? in_sizes[0] : -1, out_size, ws_size); grid = -1; return; }
        int dev = 0, cus = 0, per_cu = 0;
        if (hipGetDevice(&dev) != hipSuccess || hipDeviceGetAttribute(&cus, hipDeviceAttributeMultiprocessorCount, dev) != hipSuccess) { grid = -1; return; }
        if (hipFuncSetAttribute((const void*)layer_fwd, hipFuncAttributeMaxDynamicSharedMemorySize, LDS_BYTES) != hipSuccess) { fprintf(stderr, "kernel_launch: hipFuncSetAttribute failed\n"); grid = -1; return; }
        if (hipOccupancyMaxActiveBlocksPerMultiprocessor(&per_cu, (const void*)layer_fwd, NWAVES * 64, LDS_BYTES) != hipSuccess || per_cu < 1)
            fprintf(stderr, "kernel_launch: note: occupancy query reports %d workgroups per CU\n", per_cu);
        (void)hipGetLastError();
        grid = cus;
    }
    if (grid < 0) return;
    if (hipMemsetAsync((char*)d_ws + WS_CTL, 0, CTL_ZERO_BYTES, stream) != hipSuccess) { fprintf(stderr, "kernel_launch: hipMemsetAsync failed\n"); return; }
    Args a{};
    for (int i = 0; i < 13; ++i) a.in[i] = (const float*)d_in[i];
    a.out = (float*)d_out; a.ws = (unsigned char*)d_ws;
    for (int li = 0; li < N_LAUNCHES; ++li) {
        a.ph_lo = (N_LAUNCHES == 1) ? 0 : li; a.ph_hi = (N_LAUNCHES == 1) ? N_PHASES : li + 1;
        hipLaunchKernelGGL(layer_fwd, dim3(grid), dim3(NWAVES * 64), LDS_BYTES, stream, a);
        const hipError_t le = hipPeekAtLastError();
        if (le != hipSuccess) { fprintf(stderr, "kernel_launch: launch %d failed: %s\n", li, hipGetErrorName(le)); break; }
    }
}
```

```cpp
#include <hip/hip_runtime.h>
#include <cstdio>
#include <cstdint>
namespace pg8 {
#define PG8_LAS __attribute__((address_space(3)))
typedef unsigned short bf16_t;
typedef short bf16x8 __attribute__((ext_vector_type(8)));
typedef float f32x4 __attribute__((ext_vector_type(4)));
typedef unsigned u32x4 __attribute__((ext_vector_type(4)));
constexpr int BM = 256, BK = 64, HALF = 128, HTB = HALF * BK * 2  , STAGE_BYTES = 8 * HTB, NXCD = 8, WGM = 8;

__host__ __device__ __forceinline__ int lds_byte(int r, int c) { const int st = (r >> 4) * 2 + (c >> 5), rr = r & 15, cc = c & 31, ob = rr * 64 + cc * 2; return st * 1024 + (ob ^ (((ob >> 9) & 1) << 5)); }
__host__ __device__ __forceinline__ void stage_rc(int b, int& R, int& C) { const int st = b / 1024, sb = b % 1024, swz = sb ^ (((sb >> 9) & 1) << 5); R = (st >> 1) * 16 + swz / 64; C = (st & 1) * 32 + (swz % 64) / 2; }
__host__ __device__ __forceinline__ int perm32(int rho) { const int n = rho >> 4, i = rho & 15; return 8 * (i >> 2) + 4 * n + (i & 3); }

struct Unit { int pm, pn; };
struct Gemm { const bf16_t* A; const bf16_t* Bt; int M, N, K, lda; };

struct StaticOrder {
    int nM, nN, nwg, G, c;
    __host__ __device__ void init(int M, int N, int G_, int c_) { nM = M / BM; nN = N / BM; nwg = nM * nN; G = G_; c = c_; }
    __host__ __device__ bool next(int i, Unit& u) const {
        const long L = (long)i * G + c; if (L >= nwg) return false;
        int wgid = (int)L; { const int q = nwg / NXCD, r = nwg % NXCD, xcd = wgid % NXCD, off = wgid / NXCD; wgid = (xcd < r ? xcd * (q + 1) : r * (q + 1) + (xcd - r) * q) + off; }
        const int nig = WGM * nN, gid = wgid / nig, fm = gid * WGM, gsz = (nM - fm) < WGM ? (nM - fm) : WGM;
        u.pm = fm + ((wgid % nig) % gsz); u.pn = (wgid % nig) / gsz; return true;
    }
    __device__ __forceinline__ void a_ready(const Unit&) const {}
    __device__ __forceinline__ void done(const Unit&) const {}
};
__device__ __forceinline__ unsigned cvt_pk_bf16(float lo, float hi) { unsigned r; asm volatile("v_cvt_pk_bf16_f32 %0, %1, %2" : "=v"(r) : "v"(lo), "v"(hi)); return r; }
__device__ __forceinline__ float sigmoidf_fast(float x) { return __builtin_amdgcn_rcpf(1.0f + __builtin_amdgcn_exp2f(-1.4426950408889634f * x)); }
__device__ __forceinline__ float bf_lo(unsigned w) { return __uint_as_float(w << 16); }
__device__ __forceinline__ float bf_hi(unsigned w) { return __uint_as_float(w & 0xffff0000u); }

struct EpiF32 {
    static constexpr bool PERM = false, AFTER_DRAIN = false, HAS_MID = false;
    float* C; int ldc; int kmid;
    __device__ __forceinline__ void mid(f32x4 (&)[2][2][4][2], const Unit&, int, int, int, int) const {}
    __device__ __forceinline__ void operator()(const f32x4 (&acc)[2][2][4][2], const Unit& u, int wr, int wc, int fr, int fq) const {
        const int row0 = u.pm * BM + wr * 64 + fr, col0 = u.pn * BM + wc * 32 + 4 * fq;
#pragma unroll
        for (int ai = 0; ai < 2; ++ai)
#pragma unroll
            for (int m = 0; m < 4; ++m) { float* rowp = C + (size_t)(row0 + ai * HALF + m * 16) * ldc + col0;
#pragma unroll
                for (int bj = 0; bj < 2; ++bj)
#pragma unroll
                    for (int n = 0; n < 2; ++n) *(f32x4*)(rowp + bj * HALF + n * 16) = acc[ai][bj][m][n]; }
    }
};
struct EpiProj {
    static constexpr bool PERM = true, AFTER_DRAIN = false, HAS_MID = false;
    bf16_t* QKV; bf16_t* G; int ldq, ldg, nqt, nscale; float qscale; int kmid;
    __device__ __forceinline__ void mid(f32x4 (&)[2][2][4][2], const Unit&, int, int, int, int) const {}
    __device__ __forceinline__ void operator()(const f32x4 (&acc)[2][2][4][2], const Unit& u, int wr, int wc, int fr, int fq) const {
        const int row0 = u.pm * BM + wr * 64 + fr; const bool gate = u.pn >= nqt;
        bf16_t* base = gate ? G : QKV; const int ldc = gate ? ldg : ldq; const int colt = (gate ? (u.pn - nqt) : u.pn) * BM;
        const float sc = (u.pn < nscale) ? qscale : 1.0f;
        const int col0 = colt + wc * 32 + 8 * fq;
#pragma unroll
        for (int ai = 0; ai < 2; ++ai)
#pragma unroll
            for (int m = 0; m < 4; ++m) { bf16_t* rowp = base + (size_t)(row0 + ai * HALF + m * 16) * ldc + col0;
#pragma unroll
                for (int bj = 0; bj < 2; ++bj) { f32x4 v0 = acc[ai][bj][m][0], v1 = acc[ai][bj][m][1];
                    if (gate) {
#pragma unroll
                        for (int j = 0; j < 4; ++j) { v0[j] = sigmoidf_fast(v0[j]); v1[j] = sigmoidf_fast(v1[j]); } }
                    else { v0 = v0 * sc; v1 = v1 * sc; }
                    u32x4 w; w.x = cvt_pk_bf16(v0[0], v0[1]); w.y = cvt_pk_bf16(v0[2], v0[3]); w.z = cvt_pk_bf16(v1[0], v1[1]); w.w = cvt_pk_bf16(v1[2], v1[3]);
                    *(u32x4*)(rowp + bj * HALF) = w; } }
    }
};
struct EpiBranch {
    static constexpr bool PERM = true, AFTER_DRAIN = false, HAS_MID = true;
    bf16_t* O; float* T; const bf16_t* G; int ldc, ldg, goff2; int kmid;
    __device__ __forceinline__ void mid(f32x4 (&acc)[2][2][4][2], const Unit& u, int wr, int wc, int fr, int fq) const {
        unsigned row0 = u.pm * BM + wr * 64 + fr, col0 = u.pn * BM + wc * 32 + 8 * fq;
        asm volatile("" : "+v"(row0), "+v"(col0));
        const char* Gb = (const char*)G; char* Tb = (char*)T;
#pragma unroll
        for (int ai = 0; ai < 2; ++ai)
#pragma unroll
            for (int m = 0; m < 4; ++m) { const unsigned r = row0 + ai * HALF + m * 16; const unsigned go = (r * (unsigned)ldg + col0) * 2u, to = (r * (unsigned)ldc + col0) * 4u;
#pragma unroll
                for (int bj = 0; bj < 2; ++bj) { const u32x4 g = *(const u32x4*)(Gb + (size_t)(go + bj * HALF * 2));
                    f32x4 v0 = acc[ai][bj][m][0], v1 = acc[ai][bj][m][1];
                    v0[0] *= bf_lo(g.x); v0[1] *= bf_hi(g.x); v0[2] *= bf_lo(g.y); v0[3] *= bf_hi(g.y);
                    v1[0] *= bf_lo(g.z); v1[1] *= bf_hi(g.z); v1[2] *= bf_lo(g.w); v1[3] *= bf_hi(g.w);
                    char* tp = Tb + (size_t)(to + bj * HALF * 4); *(f32x4*)tp = v0; *(f32x4*)(tp + 16) = v1;
                    acc[ai][bj][m][0] = (f32x4){0.f, 0.f, 0.f, 0.f}; acc[ai][bj][m][1] = (f32x4){0.f, 0.f, 0.f, 0.f}; }
                asm volatile("" ::: "memory"); }
    }
    __device__ __forceinline__ void operator()(const f32x4 (&acc)[2][2][4][2], const Unit& u, int wr, int wc, int fr, int fq) const {
        const unsigned row0 = u.pm * BM + wr * 64 + fr, col0 = u.pn * BM + wc * 32 + 8 * fq;
        const char* Gb = (const char*)G; const char* Tb = (const char*)T; char* Ob = (char*)O;
#pragma unroll
        for (int ai = 0; ai < 2; ++ai)
#pragma unroll
            for (int m = 0; m < 4; ++m) { const unsigned r = row0 + ai * HALF + m * 16;
                const unsigned go = (r * (unsigned)ldg + goff2 + col0) * 2u, to = (r * (unsigned)ldc + col0) * 4u, oo = (r * (unsigned)ldc + col0) * 2u;
#pragma unroll
                for (int bj = 0; bj < 2; ++bj) { const u32x4 g = *(const u32x4*)(Gb + (size_t)(go + bj * HALF * 2));
                    const char* tp = Tb + (size_t)(to + bj * HALF * 4); const f32x4 t0 = *(const f32x4*)tp, t1 = *(const f32x4*)(tp + 16);
                    f32x4 v0 = acc[ai][bj][m][0], v1 = acc[ai][bj][m][1];
                    v0[0] = t0[0] + v0[0] * bf_lo(g.x); v0[1] = t0[1] + v0[1] * bf_hi(g.x); v0[2] = t0[2] + v0[2] * bf_lo(g.y); v0[3] = t0[3] + v0[3] * bf_hi(g.y);
                    v1[0] = t1[0] + v1[0] * bf_lo(g.z); v1[1] = t1[1] + v1[1] * bf_hi(g.z); v1[2] = t1[2] + v1[2] * bf_lo(g.w); v1[3] = t1[3] + v1[3] * bf_hi(g.w);
                    u32x4 w; w.x = cvt_pk_bf16(v0[0], v0[1]); w.y = cvt_pk_bf16(v0[2], v0[3]); w.z = cvt_pk_bf16(v1[0], v1[1]); w.w = cvt_pk_bf16(v1[2], v1[3]);
                    *(u32x4*)(Ob + (size_t)(oo + bj * HALF * 2)) = w; }
                asm volatile("" ::: "memory"); }
    }
};
struct EpiSwiGLU {
    static constexpr bool PERM = true, AFTER_DRAIN = false, HAS_MID = false;
    bf16_t* O; int ldc; int kmid;
    __device__ __forceinline__ void mid(f32x4 (&)[2][2][4][2], const Unit&, int, int, int, int) const {}
    __device__ __forceinline__ void operator()(const f32x4 (&acc)[2][2][4][2], const Unit& u, int wr, int wc, int fr, int fq) const {
        const int row0 = u.pm * BM + wr * 64 + fr, col0 = u.pn * HALF + wc * 32 + 8 * fq;
#pragma unroll
        for (int ai = 0; ai < 2; ++ai)
#pragma unroll
            for (int m = 0; m < 4; ++m) { bf16_t* rowp = O + (size_t)(row0 + ai * HALF + m * 16) * ldc + col0;
                f32x4 v0, v1;
#pragma unroll
                for (int j = 0; j < 4; ++j) { const float g0 = acc[ai][0][m][0][j], g1 = acc[ai][0][m][1][j];
                    v0[j] = g0 * sigmoidf_fast(g0) * acc[ai][1][m][0][j]; v1[j] = g1 * sigmoidf_fast(g1) * acc[ai][1][m][1][j]; }
                u32x4 w; w.x = cvt_pk_bf16(v0[0], v0[1]); w.y = cvt_pk_bf16(v0[2], v0[3]); w.z = cvt_pk_bf16(v1[0], v1[1]); w.w = cvt_pk_bf16(v1[2], v1[3]);
                *(u32x4*)rowp = w; }
    }
};
template <class Epi, class Sched, bool ALIGN_EPI = false, bool SP2 = false>
__device__ __forceinline__ void gemm_phase(PG8_LAS unsigned char* lds, const Gemm g, const Sched& S, const Epi& E) {
    const int tid = threadIdx.x, wid = __builtin_amdgcn_readfirstlane(tid >> 6), lane = tid & 63, wr = wid >> 2, wc = wid & 3, fr = lane & 15, fq = lane >> 4;
    const int K = g.K, nt = K / BK;
    unsigned voffA[2], voffB[2];
#pragma unroll
    for (int i = 0; i < 2; ++i) { int R, C; stage_rc(tid * 16 + i * 8192, R, C); const int Rb = Epi::PERM ? ((R & ~31) + perm32(R & 31)) : R;
        voffA[i] = (unsigned)(R * g.lda + C) * 2u; voffB[i] = (unsigned)(Rb * K + C) * 2u; }
    const size_t kstep = (size_t)(BK * 2);
    const size_t hstepB = (size_t)HALF * K * 2, hstepA = (size_t)HALF * g.lda * 2;
    const size_t tstepA = 2 * hstepA, tstepB = 2 * hstepB;
    const unsigned ldsw = (unsigned)wid * 1024u;
    const int aoff = lds_byte(wr * 64 + fr, fq * 8), boff = lds_byte(wc * 32 + fr, fq * 8);
#define PG8_SA(b, h) (((b) * 2 + (h)) * HTB)
#define PG8_SB(b, h) ((4 + (b) * 2 + (h)) * HTB)
#define PG8_STAGE(bufoff, gbase, voff) do { _Pragma("unroll") for (int _i = 0; _i < 2; ++_i) \
        __builtin_amdgcn_global_load_lds((const unsigned*)((const char*)(gbase) + (voff)[_i]), (PG8_LAS unsigned*)(lds + (bufoff) + ldsw + _i * 8192), 16, 0, 0); } while (0)
#define PG8_LDA(dst, b, h) do { _Pragma("unroll") for (int m = 0; m < 4; ++m) _Pragma("unroll") for (int k = 0; k < 2; ++k) dst[m][k] = *(const PG8_LAS bf16x8*)(lds + PG8_SA(b, h) + aoff + m * 2048 + k * 1024); } while (0)
#define PG8_LDB(dst, b, h) do { _Pragma("unroll") for (int n = 0; n < 2; ++n) _Pragma("unroll") for (int k = 0; k < 2; ++k) dst[n][k] = *(const PG8_LAS bf16x8*)(lds + PG8_SB(b, h) + boff + n * 2048 + k * 1024); } while (0)
#define PG8_MMA(ai, bj, At, Bt) do { __builtin_amdgcn_s_setprio(1); _Pragma("unroll") for (int m = 0; m < 4; ++m) _Pragma("unroll") for (int n = 0; n < 2; ++n) _Pragma("unroll") for (int k = 0; k < 2; ++k) \
        acc[ai][bj][m][n] = __builtin_amdgcn_mfma_f32_16x16x32_bf16(Bt[n][k], At[m][k], acc[ai][bj][m][n], 0, 0, 0); __builtin_amdgcn_s_setprio(0); } while (0)
#define PG8_WAIT_V(n) asm volatile("s_waitcnt vmcnt(" #n ")" ::: "memory")
#define PG8_WAIT_L(n) asm volatile("s_waitcnt lgkmcnt(" #n ")" ::: "memory")
#define PG8_BAR __builtin_amdgcn_s_barrier()
#define PG8_SCHED __builtin_amdgcn_sched_barrier(0)
    Unit cur, nxt; int ui = 0;
    if (!S.next(0, cur)) return;
    f32x4 acc[2][2][4][2];
#pragma unroll
    for (int a = 0; a < 2; ++a)
#pragma unroll
        for (int b = 0; b < 2; ++b)
#pragma unroll
            for (int m = 0; m < 4; ++m)
#pragma unroll
                for (int n = 0; n < 2; ++n) acc[a][b][m][n] = (f32x4){0.f, 0.f, 0.f, 0.f};
    bf16x8 At[4][2], B0[2][2], B1[2][2];
    const char* cA = (const char*)g.A + (size_t)cur.pm * tstepA; const char* cB = (const char*)g.Bt + (size_t)cur.pn * tstepB;
    S.a_ready(cur);
    if constexpr (SP2) {
        PG8_STAGE(PG8_SB(0, 0), cB, voffB); PG8_STAGE(PG8_SB(0, 1), cB + hstepB, voffB); PG8_STAGE(PG8_SA(0, 0), cA, voffA); PG8_STAGE(PG8_SA(0, 1), cA + hstepA, voffA);
        if (wr == 1) PG8_BAR;
        PG8_WAIT_V(2); PG8_BAR;
        PG8_STAGE(PG8_SB(1, 0), cB + kstep, voffB); PG8_STAGE(PG8_SA(1, 0), cA + kstep, voffA); PG8_STAGE(PG8_SB(1, 1), cB + hstepB + kstep, voffB);
        PG8_WAIT_V(6); PG8_BAR;
    } else {
        PG8_STAGE(PG8_SB(0, 0), cB, voffB); PG8_STAGE(PG8_SA(0, 0), cA, voffA); PG8_STAGE(PG8_SB(0, 1), cB + hstepB, voffB); PG8_STAGE(PG8_SA(0, 1), cA + hstepA, voffA);
        if (wr == 1) PG8_BAR;
        PG8_WAIT_V(4); PG8_BAR;
        PG8_STAGE(PG8_SB(1, 0), cB + kstep, voffB); PG8_STAGE(PG8_SA(1, 0), cA + kstep, voffA); PG8_STAGE(PG8_SB(1, 1), cB + hstepB + kstep, voffB);
        PG8_WAIT_V(6); PG8_BAR;
    }
    for (;;) {
        const bool has_next = S.next(ui + 1, nxt);
        const char* nA = has_next ? (const char*)g.A + (size_t)nxt.pm * tstepA : cA; const char* nB = has_next ? (const char*)g.Bt + (size_t)nxt.pn * tstepB : cB;
        for (int t = 0; t < nt; t += 2) {
            if constexpr (Epi::HAS_MID) { if (t == E.kmid) E.mid(acc, cur, wr, wc, fr, fq); }
            const bool last = (t == nt - 2);
            const char* a1 = cA + (size_t)(t + 1) * kstep;
            const char* a2 = last ? nA : cA + (size_t)(t + 2) * kstep; const char* b2 = last ? nB : cB + (size_t)(t + 2) * kstep;
            const char* a3 = a2 + kstep; const char* b3 = b2 + kstep;
            if (last && has_next) S.a_ready(nxt);
            if constexpr (SP2) {
            PG8_LDB(B0, 0, 0); PG8_LDB(B1, 0, 1); PG8_SCHED; PG8_LDA(At, 0, 0); PG8_STAGE(PG8_SA(1, 1), a1 + hstepA, voffA);
            PG8_WAIT_V(8); PG8_WAIT_L(0); PG8_BAR; PG8_MMA(0, 0, At, B0); PG8_MMA(0, 1, At, B1); PG8_BAR; PG8_SCHED;
            PG8_LDA(At, 0, 1); PG8_STAGE(PG8_SB(0, 0), b2, voffB); PG8_STAGE(PG8_SB(0, 1), b2 + hstepB, voffB); PG8_STAGE(PG8_SA(0, 0), a2, voffA);
            PG8_WAIT_V(8); PG8_WAIT_L(0); PG8_BAR; PG8_MMA(1, 0, At, B0); PG8_MMA(1, 1, At, B1); PG8_BAR; PG8_SCHED;
            PG8_LDB(B0, 1, 0); PG8_LDB(B1, 1, 1); PG8_SCHED; PG8_LDA(At, 1, 0); PG8_STAGE(PG8_SA(0, 1), a2 + hstepA, voffA);
            PG8_WAIT_V(8); PG8_WAIT_L(0); PG8_BAR; PG8_MMA(0, 0, At, B0); PG8_MMA(0, 1, At, B1); PG8_BAR; PG8_SCHED;
            PG8_LDA(At, 1, 1); PG8_STAGE(PG8_SB(1, 0), b3, voffB); PG8_STAGE(PG8_SB(1, 1), b3 + hstepB, voffB); PG8_STAGE(PG8_SA(1, 0), a3, voffA);
            PG8_WAIT_V(8); PG8_WAIT_L(0); PG8_BAR; PG8_MMA(1, 0, At, B0); PG8_MMA(1, 1, At, B1); PG8_BAR; PG8_SCHED;
            } else {
            PG8_LDB(B0, 0, 0); PG8_SCHED; PG8_LDA(At, 0, 0); PG8_STAGE(PG8_SA(1, 1), a1 + hstepA, voffA);
            PG8_WAIT_L(8); PG8_BAR; PG8_WAIT_L(0); PG8_MMA(0, 0, At, B0); PG8_BAR; PG8_SCHED;
            PG8_LDB(B1, 0, 1); PG8_STAGE(PG8_SB(0, 0), b2, voffB);
            PG8_BAR; PG8_WAIT_L(0); PG8_MMA(0, 1, At, B1); PG8_BAR;
            PG8_LDA(At, 0, 1); PG8_STAGE(PG8_SA(0, 0), a2, voffA);
            PG8_BAR; PG8_WAIT_L(0); PG8_MMA(1, 0, At, B0); PG8_BAR; PG8_SCHED;
            PG8_STAGE(PG8_SB(0, 1), b2 + hstepB, voffB);
            PG8_WAIT_V(6); PG8_BAR; PG8_MMA(1, 1, At, B1); PG8_BAR;
            PG8_LDB(B0, 1, 0); PG8_SCHED; PG8_LDA(At, 1, 0); PG8_STAGE(PG8_SA(0, 1), a2 + hstepA, voffA);
            PG8_WAIT_L(8); PG8_BAR; PG8_WAIT_L(0); PG8_MMA(0, 0, At, B0); PG8_BAR; PG8_SCHED;
            PG8_LDB(B1, 1, 1); PG8_STAGE(PG8_SB(1, 0), b3, voffB);
            PG8_BAR; PG8_WAIT_L(0); PG8_MMA(0, 1, At, B1); PG8_BAR;
            PG8_LDA(At, 1, 1); PG8_STAGE(PG8_SA(1, 0), a3, voffA);
            PG8_BAR; PG8_WAIT_L(0); PG8_MMA(1, 0, At, B0); PG8_BAR; PG8_SCHED;
            PG8_STAGE(PG8_SB(1, 1), b3 + hstepB, voffB);
            PG8_WAIT_V(6); PG8_BAR; PG8_MMA(1, 1, At, B1); PG8_BAR;
            }
        }
        if constexpr (ALIGN_EPI) { if (wr == 0) PG8_BAR; }
        if constexpr (!Epi::AFTER_DRAIN) { E(acc, cur, wr, wc, fr, fq); S.done(cur); }
        if (!has_next) break;
#pragma unroll
        for (int a = 0; a < 2; ++a)
#pragma unroll
            for (int b = 0; b < 2; ++b)
#pragma unroll
                for (int m = 0; m < 4; ++m)
#pragma unroll
                    for (int n = 0; n < 2; ++n) acc[a][b][m][n] = (f32x4){0.f, 0.f, 0.f, 0.f};
        cur = nxt; cA = nA; cB = nB; ++ui;
        if constexpr (ALIGN_EPI) { if (wr == 1) PG8_BAR; }
    }
    PG8_WAIT_V(0);
    if constexpr (!ALIGN_EPI) { if (wr == 0) PG8_BAR; }
    PG8_BAR;
    if constexpr (Epi::AFTER_DRAIN) { E.fused(acc, cur, wr, wc, fr, fq, lds, wid, lane); S.done(cur); }
#undef PG8_SA
#undef PG8_SB
#undef PG8_STAGE
#undef PG8_LDA
#undef PG8_LDB
#undef PG8_MMA
#undef PG8_WAIT_V
#undef PG8_WAIT_L
#undef PG8_BAR
#undef PG8_SCHED
}
}
#ifndef PG8_SP2
#define PG8_SP2 true
#endif
constexpr int NWAVES = 8;
#ifndef MK_N_LAUNCHES
#define MK_N_LAUNCHES 1
#endif
constexpr int N_PHASES = 9;
constexpr int N_LAUNCHES = MK_N_LAUNCHES;
static_assert(N_LAUNCHES == 1 || N_LAUNCHES == N_PHASES, "MK_N_LAUNCHES is 1 or 9");

constexpr int BATCH = 8, SEQ = 2048, DM = 2048, NH = 8, HD = 128, DSB = 1024, DIN = 10248, FF = 5632;
constexpr int M = BATCH * SEQ;
constexpr int NPROJ = 10240;
constexpr int NQKV = 6144, NGATE = 4096, NGU = 2 * FF;
constexpr int COL_QSB = 0, COL_QFX = 1024, COL_KSB = 2048, COL_VSB = 3072, COL_KFX = 4096, COL_VFX = 5120;
constexpr float RMS_EPS = 1e-6f;
constexpr float LOG2E = 1.4426950408889634f;
constexpr float QSCALE = 0.08838834764831845f * LOG2E;

constexpr size_t MiB = 1u << 20;
constexpr size_t WS_CTL = 0, CTL_ZERO_BYTES = 1 * MiB;
constexpr size_t WS_WIN = 2 * MiB;
constexpr size_t WS_WBR = 42 * MiB;
constexpr size_t WS_WOUT = 50 * MiB;
constexpr size_t WS_WGU = 58 * MiB;
constexpr size_t WS_WDN = 102 * MiB;
constexpr size_t WS_U = 124 * MiB;
constexpr size_t WS_QKV = 188 * MiB;
constexpr size_t WS_G = 380 * MiB;
constexpr size_t WS_MIX = 188 * MiB;
constexpr size_t WS_HDN = 188 * MiB;
constexpr size_t WS_FFO = 380 * MiB;
constexpr size_t WS_LOGF = 508 * MiB;
constexpr size_t WS_CUM = 508 * MiB + 512 * 1024;
constexpr size_t WS_END = 509 * MiB;
constexpr int CW_TMO = 0, CW_CODE = 1;
constexpr int CW_BAR = 4096;

constexpr int RING_OFF = 0, RING_BYTES = 131072;
constexpr int LDSCTL_OFF = RING_BYTES, MISC_OFF = LDSCTL_OFF + 320;
constexpr int LDS_BYTES = 147456;
static_assert(MISC_OFF + 128 <= LDS_BYTES, "LDS map");
#define GAS __attribute__((address_space(1)))
#define LAS __attribute__((address_space(3)))
typedef unsigned short bf16;
typedef unsigned v4u __attribute__((ext_vector_type(4)));
typedef float f32x4 __attribute__((ext_vector_type(4)));
typedef short bf16x8 __attribute__((ext_vector_type(8)));
typedef GAS unsigned gu32;
typedef GAS unsigned long long gu64;
#define RLX_AGENT __ATOMIC_RELAXED, __HIP_MEMORY_SCOPE_AGENT
#define LDS_WAIT() asm volatile("s_waitcnt lgkmcnt(0)" ::: "memory")
#define VM_WAIT() asm volatile("s_waitcnt vmcnt(0)" ::: "memory")
__device__ __forceinline__ unsigned long long rt() { return __builtin_amdgcn_s_memrealtime(); }
__device__ __forceinline__ unsigned f2bf(float f) { unsigned u = __builtin_bit_cast(unsigned, f); return (u + 0x7fffu + ((u >> 16) & 1u)) >> 16; }
__device__ __forceinline__ unsigned pk2(float lo, float hi) { return f2bf(lo) | (f2bf(hi) << 16); }

#define XB_TMO      128
#define XB_XCNT(j)  (256  + 64 * (j))
#define XB_XSUB(j)  (1280 + 64 * (j))
#define XB_XGEN(j)  (2304 + 64 * (j))
#define XB_TOP      3328
#define XB_TOPGEN   3392
#define XCD_BAR_WORDS 3456
#define XB_SPIN_CAP (1u << 18)

__device__ __forceinline__ unsigned xb_ld(unsigned* p)              { return __hip_atomic_load(p, __ATOMIC_RELAXED, __HIP_MEMORY_SCOPE_AGENT); }
__device__ __forceinline__ unsigned xb_add(unsigned* p, unsigned v) { return __hip_atomic_fetch_add(p, v, __ATOMIC_RELAXED, __HIP_MEMORY_SCOPE_AGENT); }
__device__ __forceinline__ unsigned xb_xcc_id() { return (unsigned)__builtin_amdgcn_s_getreg((3 << 11) | 20) & 0xFu; }
#define XB_SPIN(cond, bar) do { unsigned _sp = 0; while (cond) { __builtin_amdgcn_s_sleep(1); \
    if ((++_sp & 255u) == 0u) { if (xb_ld(&(bar)[XB_TMO])) break; if (_sp > XB_SPIN_CAP) { atomicAdd(&(bar)[XB_TMO], 1u); break; } } } } while (0)

struct XcdBarrier {
    unsigned* bar; unsigned x;
    volatile LAS unsigned* st;
};

__device__ __forceinline__ XcdBarrier xcd_barrier_post(unsigned* bar, volatile LAS unsigned* st) {
    XcdBarrier b; b.bar = bar; b.x = xb_xcc_id(); b.st = st;
    if (threadIdx.x == 0) (void)xb_add(&bar[XB_XCNT(b.x)], 1u);
    return b;
}
__device__ __forceinline__ void xcd_barrier_complete(unsigned* bar, unsigned x, unsigned& nloc, unsigned& nx) {
    const unsigned G = gridDim.x * gridDim.y * gridDim.z;
    unsigned sum, cnt, mine, sp = 0u;
    for (;;) {
        sum = 0u; cnt = 0u; mine = 0u;
#pragma unroll
        for (unsigned j = 0; j < 16; ++j) { const unsigned c = xb_ld(&bar[XB_XCNT(j)]); sum += c; cnt += (c > 0u) ? 1u : 0u; mine = (j == x) ? c : mine; }
        if (sum == G) break;
        __builtin_amdgcn_s_sleep(1);
        if ((++sp & 255u) == 0u) { if (xb_ld(&bar[XB_TMO])) break; if (sp > XB_SPIN_CAP) { atomicAdd(&bar[XB_TMO], 1u); break; } }
    }
    nloc = mine > 0u ? mine : 1u; nx = cnt > 0u ? cnt : 1u;
}

__device__ __forceinline__ void xcd_barrier(const XcdBarrier& b) {
    asm volatile("s_waitcnt vmcnt(0)" ::: "memory");
    __syncthreads();
    if (threadIdx.x == 0) {
        unsigned* bar = b.bar;
        __builtin_amdgcn_s_waitcnt(0);
        unsigned nloc = b.st[0], nx = b.st[1];
        if (nloc == 0u) { xcd_barrier_complete(bar, b.x, nloc, nx); b.st[0] = nloc; b.st[1] = nx; }
        const unsigned old = xb_add(&bar[XB_XSUB(b.x)], 1u);
        const unsigned gen = old / nloc;
        if (old + 1u == (gen + 1u) * nloc) {
            __builtin_amdgcn_fence(__ATOMIC_RELEASE, "agent");
            asm volatile("s_waitcnt vmcnt(0)" ::: "memory");
            const unsigned og = xb_add(&bar[XB_TOP], 1u);
            const unsigned tg = og / nx;
            if (og + 1u == (tg + 1u) * nx) xb_add(&bar[XB_TOPGEN], 1u);
            else XB_SPIN(xb_ld(&bar[XB_TOPGEN]) == tg, bar);
            __builtin_amdgcn_fence(__ATOMIC_ACQUIRE, "agent");
            xb_add(&bar[XB_XGEN(b.x)], 1u);
            asm volatile("s_waitcnt vmcnt(0)" ::: "memory");
        } else {
            XB_SPIN(xb_ld(&bar[XB_XGEN(b.x)]) == gen, bar);
            __builtin_amdgcn_fence(__ATOMIC_ACQUIRE, "agent");
            asm volatile("s_waitcnt vmcnt(0)" ::: "memory");
        }
    }
    __syncthreads();
}
struct Frame {
    LAS unsigned char* lds;
    volatile LAS unsigned* MISC;
    gu32* ctl;
    int tid, lane, wave;
    int vcu, G;
    const float* x; float* out;
    const float *g_mix_pre, *g_mix_post, *w_in, *b_forget, *w_bsb, *w_bfx, *w_out, *g_ffn_pre, *g_ffn_post, *w_gate, *w_up, *w_down;
    bf16 *Win_t, *Wbr_t, *Wout_t, *Wgu_t, *Wdn_t;
    bf16 *U, *QKV, *GT, *HDN;
    float *MIX, *FFO, *LOGF, *CUM;
};

__device__ __forceinline__ float wave_sum(float v) {
#pragma unroll
    for (int o = 1; o < 64; o <<= 1) v += __shfl_xor(v, o);
    return v;
}
__device__ __forceinline__ void tr_item(const float* W, int Npitch, int ncol0, bf16* WT, int dpitch, int drow0, int dk0, LAS float* scr, int kb, int lane) {
    const int k0 = 64 * kb;
#pragma unroll 8
    for (int i = 0; i < 32; ++i) { const int kk = 2 * i + (lane >> 5); scr[kk * 33 + (lane & 31)] = W[(size_t)(k0 + kk) * Npitch + ncol0 + (lane & 31)]; }
    LDS_WAIT(); asm volatile("" ::: "memory");
    const int c = lane & 7;
#pragma unroll
    for (int j = 0; j < 4; ++j) { const int n = (lane >> 3) + 8 * j; const LAS float* s = scr + (8 * c) * 33 + n;
        v4u o; o.x = pk2(s[0 * 33], s[1 * 33]); o.y = pk2(s[2 * 33], s[3 * 33]); o.z = pk2(s[4 * 33], s[5 * 33]); o.w = pk2(s[6 * 33], s[7 * 33]);
        *(GAS v4u*)(WT + (size_t)(drow0 + n) * dpitch + dk0 + k0 + 8 * c) = o; }
    LDS_WAIT(); asm volatile("" ::: "memory");
}
struct Seg { const float* W; int K, Npitch, n0, ncols; bf16* WT; int dpitch, drow0, dk0, rowmode; };
__device__ __forceinline__ int seg_items(const Seg& s) { return (s.K / 64) * (s.ncols / 32); }
__device__ __forceinline__ void seg_item(const Seg& s, int item, LAS float* scr, int lane) {
    const int nblk = s.ncols / 32, kb = item / nblk, nb = item % nblk, n = 32 * nb;
    int drow = s.drow0 + n;
    if (s.rowmode) drow = 256 * (n >> 7) + (n & 127) + (s.rowmode == 2 ? 128 : 0);
    tr_item(s.W, s.Npitch, s.n0 + n, s.WT, s.dpitch, drow, s.dk0, scr, kb, lane);
}

__device__ __forceinline__ void p0_prologue(Frame& F) {
    LAS float* scr = (LAS float*)(F.lds + RING_OFF + F.wave * 16384);
    const int gw = F.vcu * NWAVES + F.wave, NGW = F.G * NWAVES;
    {
        const Seg segs[11] = {
            {F.w_in, DM, DIN, 0, 1024, F.Win_t, DM, 0, 0, 0},
            {F.w_in, DM, DIN, 1024, 2048, F.Win_t, DM, 2048, 0, 0},
            {F.w_in, DM, DIN, 3072, 1024, F.Win_t, DM, 1024, 0, 0},
            {F.w_in, DM, DIN, 4096, 2048, F.Win_t, DM, 4096, 0, 0},
            {F.w_in, DM, DIN, 6152, 4096, F.Win_t, DM, 6144, 0, 0},
            {F.w_bsb, DSB, DM, 0, DM, F.Wbr_t, 2 * DSB, 0, 0, 0},
            {F.w_bfx, DSB, DM, 0, DM, F.Wbr_t, 2 * DSB, 0, DSB, 0},
            {F.w_out, DM, DM, 0, DM, F.Wout_t, DM, 0, 0, 0},
            {F.w_gate, DM, FF, 0, FF, F.Wgu_t, DM, 0, 0, 1},
            {F.w_up, DM, FF, 0, FF, F.Wgu_t, DM, 0, 0, 2},
            {F.w_down, FF, DM, 0, DM, F.Wdn_t, FF, 0, 0, 0},
        };
        int base = 0;
#pragma unroll
        for (int si = 0; si < 11; ++si) {
            const int ni = seg_items(segs[si]);
            int first = (gw - (base % NGW) + NGW) % NGW;
            for (int it = first; it < ni; it += NGW) seg_item(segs[si], it, scr, F.lane);
            base += ni;
        }
    }
    __syncthreads();
    LAS float* Wf = (LAS float*)(F.lds + RING_OFF);
    for (int k = F.tid; k < DM; k += NWAVES * 64) {
        const float g = F.g_mix_pre[k];
        const f32x4 a = *(const GAS f32x4*)(F.w_in + (size_t)k * DIN + 6144), b = *(const GAS f32x4*)(F.w_in + (size_t)k * DIN + 6148);
        Wf[0 * DM + k] = g * a.x; Wf[1 * DM + k] = g * a.y; Wf[2 * DM + k] = g * a.z; Wf[3 * DM + k] = g * a.w;
        Wf[4 * DM + k] = g * b.x; Wf[5 * DM + k] = g * b.y; Wf[6 * DM + k] = g * b.z; Wf[7 * DM + k] = g * b.w;
    }
    __syncthreads();
    const float bfh = F.b_forget[F.lane & 7];
    for (int m = gw; m < M; m += NGW) {
        const GAS f32x4* xr = (const GAS f32x4*)(F.x + (size_t)m * DM) + F.lane;
        f32x4 v[8]; float s = 0.f;
#pragma unroll
        for (int j = 0; j < 8; ++j) { v[j] = xr[64 * j]; s += (v[j].x * v[j].x + v[j].y * v[j].y) + (v[j].z * v[j].z + v[j].w * v[j].w); }
        const float rstd = 1.0f / sqrtf(wave_sum(s) * (1.f / DM) + RMS_EPS);
        float mine = 0.f;
#pragma unroll 1
        for (int h = 0; h < 8; ++h) { float a = 0.f;
#pragma unroll
            for (int j = 0; j < 8; ++j) { const f32x4 w = *(const LAS f32x4*)(Wf + h * DM + 256 * j + 4 * F.lane); a += (v[j].x * w.x + v[j].y * w.y) + (v[j].z * w.z + v[j].w * w.w); }
            const float t = wave_sum(a); if ((F.lane & 7) == h) mine = t; }
        GAS unsigned long long* o8 = (GAS unsigned long long*)(F.U + (size_t)m * DM) + F.lane;
#pragma unroll
        for (int j = 0; j < 8; ++j) { const f32x4 gj = ((const GAS f32x4*)F.g_mix_pre)[64 * j + F.lane]; const f32x4 u = v[j] * rstd * gj;
            o8[64 * j] = (unsigned long long)pk2(u.x, u.y) | ((unsigned long long)pk2(u.z, u.w) << 32); }
        if (F.lane < 8) { const float y = mine * rstd + bfh;
            F.LOGF[(size_t)m * 8 + F.lane] = -(fmaxf(-y, 0.f) + log1pf(expf(-fabsf(y)))); }
    }
}

__device__ __forceinline__ void cumsum_step(Frame& F) {
    if (F.vcu < BATCH * NH) {
        const int bh = F.vcu, b = bh / NH, h = bh % NH;
        LAS float* part = (LAS float*)(F.lds + RING_OFF);
        float v[4]; float run = 0.f;
#pragma unroll
        for (int i = 0; i < 4; ++i) { run += F.LOGF[(size_t)(b * SEQ + 4 * F.tid + i) * 8 + h]; v[i] = run; }
        float inc = run;
#pragma unroll
        for (int o = 1; o < 64; o <<= 1) { const float t = __shfl_up(inc, o); if (F.lane >= o) inc += t; }
        if (F.lane == 63) part[F.wave] = inc;
        __syncthreads();
        float woff = 0.f;
        for (int w = 0; w < F.wave; ++w) woff += part[w];
        const float off = woff + inc - run;
#pragma unroll
        for (int i = 0; i < 4; ++i) F.CUM[(size_t)bh * SEQ + 4 * F.tid + i] = off + v[i];
    }
    __syncthreads();
}

__device__ __forceinline__ void unpack8(const v4u w, float* f) {
    f[0] = __uint_as_float(w.x << 16); f[1] = __uint_as_float(w.x & 0xffff0000u); f[2] = __uint_as_float(w.y << 16); f[3] = __uint_as_float(w.y & 0xffff0000u);
    f[4] = __uint_as_float(w.z << 16); f[5] = __uint_as_float(w.z & 0xffff0000u); f[6] = __uint_as_float(w.w << 16); f[7] = __uint_as_float(w.w & 0xffff0000u);
}
__device__ __forceinline__ void naive_attn_item(Frame& F, int br, int b, int h, int qb) {
    LAS bf16* Ks = (LAS bf16*)(F.lds + RING_OFF); LAS bf16* Vs = Ks + 64 * HD;
    const int row = F.tid >> 2, part = F.tid & 3, t = qb * 128 + row;
    const size_t grow = (size_t)(b * SEQ + t);
    const bf16* qp = F.QKV + grow * NQKV + (br ? COL_QFX : COL_QSB) + h * HD + part * 32;
    float q[32], o[32];
#pragma unroll
    for (int c = 0; c < 4; ++c) { unpack8(*(const GAS v4u*)(qp + 8 * c), q + 8 * c); }
#pragma unroll
    for (int i = 0; i < 32; ++i) o[i] = 0.f;
    const int kcol = (br ? COL_KFX : COL_KSB) + h * HD, vcol = (br ? COL_VFX : COL_VSB) + h * HD;
    const float* cum = F.CUM + (size_t)(b * NH + h) * SEQ;
    const float cq = br ? cum[t] * LOG2E : 0.f;
    float mrun = -1e30f, lrun = 0.f, carry = 0.f;
    const int NT = (qb * 128 + 128) / 64;
    for (int it = 0; it < NT; ++it) {
        const int jt = br ? it : NT - 1 - it;
        __syncthreads();
#pragma unroll
        for (int i = 0; i < 2; ++i) { const int idx = F.tid + 512 * i, r = idx >> 4, c = (idx & 15) * 8; const size_t gr = (size_t)(b * SEQ + jt * 64 + r) * NQKV;
            *(LAS v4u*)(Ks + r * HD + c) = *(const GAS v4u*)(F.QKV + gr + kcol + c); *(LAS v4u*)(Vs + r * HD + c) = *(const GAS v4u*)(F.QKV + gr + vcol + c); }
        __syncthreads();
        for (int kk = 0; kk < 64; ++kk) {
            const int si = br ? kk : 63 - kk, s = jt * 64 + si;
            float d = 0.f; float kf[8];
#pragma unroll
            for (int c = 0; c < 4; ++c) { unpack8(*(const LAS v4u*)(Ks + si * HD + part * 32 + 8 * c), kf);
#pragma unroll
                for (int e = 0; e < 8; ++e) d += q[8 * c + e] * kf[e]; }
            d += __shfl_xor(d, 1); d += __shfl_xor(d, 2);
            float wgt = 0.f, alpha = 1.f;
            if (br) {
                if (s <= t) { const float logit = d + cq - cum[s] * LOG2E; const float mn = fmaxf(mrun, logit);
                    alpha = exp2f(mrun - mn); wgt = exp2f(logit - mn); lrun = lrun * alpha + wgt; mrun = mn; }
            } else {
                if (s < t) { const float e = exp2f(-fabsf(d)); const float l2 = log2f(1.0f + e); const float sp = fmaxf(d, 0.f) + l2;
                    wgt = exp2f((d - sp) - carry); carry += sp; }
            }
#pragma unroll
            for (int c = 0; c < 4; ++c) { unpack8(*(const LAS v4u*)(Vs + si * HD + part * 32 + 8 * c), kf);
#pragma unroll
                for (int e = 0; e < 8; ++e) o[8 * c + e] = o[8 * c + e] * alpha + wgt * kf[e]; }
        }
    }
    const float inv = br ? 1.0f / lrun : 1.0f;
    bf16* op = F.QKV + grow * NQKV + (br ? 1024 : 0) + h * HD + part * 32;
#pragma unroll
    for (int c = 0; c < 4; ++c) { v4u w; w.x = pk2(o[8 * c] * inv, o[8 * c + 1] * inv); w.y = pk2(o[8 * c + 2] * inv, o[8 * c + 3] * inv);
        w.z = pk2(o[8 * c + 4] * inv, o[8 * c + 5] * inv); w.w = pk2(o[8 * c + 6] * inv, o[8 * c + 7] * inv); *(GAS v4u*)(op + 8 * c) = w; }
}
__device__ __forceinline__ void naive_attn_phase(Frame& F) {
    for (int i = blockIdx.x; i < 16 * 128; i += F.G) { const int qb = i >> 7, br = (i >> 6) & 1, bh = i & 63; naive_attn_item(F, br, bh / NH, bh % NH, qb); }
    __syncthreads();
}

__device__ __forceinline__ void p5_rows(Frame& F) {
    const int gw = F.vcu * NWAVES + F.wave, NGW = F.G * NWAVES;
    for (int m = gw; m < M; m += NGW) {
        const GAS f32x4* mr = (const GAS f32x4*)(F.MIX + (size_t)m * DM) + F.lane;
        const GAS f32x4* xr = (const GAS f32x4*)(F.x + (size_t)m * DM) + F.lane;
        f32x4 v[8], xv[8]; float s = 0.f;
#pragma unroll
        for (int j = 0; j < 8; ++j) { v[j] = mr[64 * j]; xv[j] = xr[64 * j]; s += (v[j].x * v[j].x + v[j].y * v[j].y) + (v[j].z * v[j].z + v[j].w * v[j].w); }
        const float rstd = 1.0f / sqrtf(wave_sum(s) * (1.f / DM) + RMS_EPS);
        float s2 = 0.f;
        GAS f32x4* orow = (GAS f32x4*)(F.out + (size_t)m * DM) + F.lane;
#pragma unroll
        for (int j = 0; j < 8; ++j) { const f32x4 g = ((const GAS f32x4*)F.g_mix_post)[64 * j + F.lane]; const f32x4 hh = xv[j] + v[j] * rstd * g; v[j] = hh; orow[64 * j] = hh;
            s2 += (hh.x * hh.x + hh.y * hh.y) + (hh.z * hh.z + hh.w * hh.w); }
        const float rstd2 = 1.0f / sqrtf(wave_sum(s2) * (1.f / DM) + RMS_EPS);
        GAS unsigned long long* o8 = (GAS unsigned long long*)(F.U + (size_t)m * DM) + F.lane;
#pragma unroll
        for (int j = 0; j < 8; ++j) { const f32x4 g = ((const GAS f32x4*)F.g_ffn_pre)[64 * j + F.lane]; const f32x4 u = v[j] * rstd2 * g;
            o8[64 * j] = (unsigned long long)pk2(u.x, u.y) | ((unsigned long long)pk2(u.z, u.w) << 32); }
    }
}
__device__ __forceinline__ void p8_rows(Frame& F) {
    const int gw = F.vcu * NWAVES + F.wave, NGW = F.G * NWAVES;
    for (int m = gw; m < M; m += NGW) {
        const GAS f32x4* fr = (const GAS f32x4*)(F.FFO + (size_t)m * DM) + F.lane;
        GAS f32x4* orow = (GAS f32x4*)(F.out + (size_t)m * DM) + F.lane;
        f32x4 v[8], hv[8]; float s = 0.f;
#pragma unroll
        for (int j = 0; j < 8; ++j) { v[j] = fr[64 * j]; hv[j] = orow[64 * j]; s += (v[j].x * v[j].x + v[j].y * v[j].y) + (v[j].z * v[j].z + v[j].w * v[j].w); }
        const float rstd = 1.0f / sqrtf(wave_sum(s) * (1.f / DM) + RMS_EPS);
#pragma unroll
        for (int j = 0; j < 8; ++j) { const f32x4 g = ((const GAS f32x4*)F.g_ffn_post)[64 * j + F.lane]; orow[64 * j] = hv[j] + v[j] * rstd * g; }
    }
}

struct Args { const float* in[13]; float* out; unsigned char* ws; int ph_lo, ph_hi; };
__global__ void __launch_bounds__(NWAVES * 64, 2) layer_fwd(Args args) {
    extern __shared__ __attribute__((aligned(16))) unsigned char lds[];
    Frame F;
    F.lds = (LAS unsigned char*)lds;
    F.MISC = (volatile LAS unsigned*)(F.lds + MISC_OFF);
    F.tid = threadIdx.x; F.lane = F.tid & 63; F.wave = __builtin_amdgcn_readfirstlane(F.tid >> 6);
    F.G = gridDim.x; { const int bx = blockIdx.x; F.vcu = (F.G % 8 == 0) ? (bx % 8) * (F.G / 8) + bx / 8 : bx; }
    unsigned char* ws = args.ws;
    F.ctl = (gu32*)(ws + WS_CTL);
    F.x = args.in[0]; F.g_mix_pre = args.in[1]; F.g_mix_post = args.in[2]; F.w_in = args.in[3]; F.b_forget = args.in[4]; F.w_bsb = args.in[5]; F.w_bfx = args.in[6];
    F.w_out = args.in[7]; F.g_ffn_pre = args.in[8]; F.g_ffn_post = args.in[9]; F.w_gate = args.in[10]; F.w_up = args.in[11]; F.w_down = args.in[12]; F.out = args.out;
    F.Win_t = (bf16*)(ws + WS_WIN); F.Wbr_t = (bf16*)(ws + WS_WBR); F.Wout_t = (bf16*)(ws + WS_WOUT); F.Wgu_t = (bf16*)(ws + WS_WGU); F.Wdn_t = (bf16*)(ws + WS_WDN);
    F.U = (bf16*)(ws + WS_U); F.QKV = (bf16*)(ws + WS_QKV); F.GT = (bf16*)(ws + WS_G); F.HDN = (bf16*)(ws + WS_HDN);
    F.MIX = (float*)(ws + WS_MIX); F.FFO = (float*)(ws + WS_FFO); F.LOGF = (float*)(ws + WS_LOGF); F.CUM = (float*)(ws + WS_CUM);
    for (int u = F.tid; u < (LDS_BYTES - LDSCTL_OFF) / 4; u += NWAVES * 64) ((LAS unsigned*)(F.lds + LDSCTL_OFF))[u] = 0u;
    __syncthreads();
    XcdBarrier bar; bar.bar = (unsigned*)(F.ctl + CW_BAR); bar.x = 0; bar.st = nullptr;
    if (N_LAUNCHES == 1) bar = xcd_barrier_post((unsigned*)(F.ctl + CW_BAR), F.MISC + 8);
#define GRID_BAR() do { if (N_LAUNCHES == 1) xcd_barrier(bar); } while (0)
    const int lo = args.ph_lo, hi = args.ph_hi;
#ifndef PH_MASK
#define PH_MASK 0x1ff
#endif
#define IN(k) (((PH_MASK >> (k)) & 1) && lo <= (k) && (k) < hi)
#define BOTH(k) (IN(k) && IN((k) + 1))

    if (IN(0)) { p0_prologue(F); if (BOTH(0)) GRID_BAR(); }
    if (IN(1)) {
        cumsum_step(F);
        pg8::Gemm g{F.U, F.Win_t, M, NPROJ, DM, DM}; pg8::StaticOrder S; S.init(M, NPROJ, F.G, (int)blockIdx.x);
        pg8::EpiProj E{F.QKV, F.GT, NQKV, NGATE, NQKV / 256, 2048 / 256, QSCALE, 0};
        pg8::gemm_phase<pg8::EpiProj, pg8::StaticOrder, true, true>(F.lds + RING_OFF, g, S, E);
        if (BOTH(1)) GRID_BAR();
    }
    if (IN(2)) { naive_attn_phase(F); if (BOTH(2)) GRID_BAR(); }
    if (IN(3)) {
        pg8::Gemm g{F.QKV, F.Wbr_t, M, DM, 2 * DSB, NQKV}; pg8::StaticOrder S; S.init(M, DM, F.G, (int)blockIdx.x);
        pg8::EpiBranch E{F.U, F.out, F.GT, DM, NGATE, DM, DSB / 64};
        pg8::gemm_phase<pg8::EpiBranch, pg8::StaticOrder, true, true>(F.lds + RING_OFF, g, S, E);
        if (BOTH(3)) GRID_BAR();
    }
    if (IN(4)) {
        pg8::Gemm g{F.U, F.Wout_t, M, DM, DM, DM}; pg8::StaticOrder S; S.init(M, DM, F.G, (int)blockIdx.x);
        pg8::EpiF32 E{F.MIX, DM, 0};
        pg8::gemm_phase<pg8::EpiF32, pg8::StaticOrder, true, true>(F.lds + RING_OFF, g, S, E);
        if (BOTH(4)) GRID_BAR();
    }
    if (IN(5)) { p5_rows(F); if (BOTH(5)) GRID_BAR(); }
    if (IN(6)) {
        pg8::Gemm g{F.U, F.Wgu_t, M, NGU, DM, DM}; pg8::StaticOrder S; S.init(M, NGU, F.G, (int)blockIdx.x);
        pg8::EpiSwiGLU E{F.HDN, FF, 0};
        pg8::gemm_phase<pg8::EpiSwiGLU, pg8::StaticOrder, true, true>(F.lds + RING_OFF, g, S, E);
        if (BOTH(6)) GRID_BAR();
    }
    if (IN(7)) {
        pg8::Gemm g{F.HDN, F.Wdn_t, M, DM, FF, FF}; pg8::StaticOrder S; S.init(M, DM, F.G, (int)blockIdx.x);
        pg8::EpiF32 E{F.FFO, DM, 0};
        pg8::gemm_phase<pg8::EpiF32, pg8::StaticOrder, true, true>(F.lds + RING_OFF, g, S, E);
        if (BOTH(7)) GRID_BAR();
    }
    if (IN(8)) { p8_rows(F); }
#undef IN
#undef BOTH
}

extern "C" void kernel_launch(void* const* d_in, const int* in_sizes, int n_in, void* d_out, int out_size, void* d_ws, size_t ws_size, hipStream_t stream) {
    static int grid = 0;
    if (grid == 0) {
        if (n_in != 13 || in_sizes[0] != M * DM || out_size != M * DM || ws_size < WS_END) {
            fprintf(stderr, "kernel_launch: unexpected shapes (n_in %d, in0 %d, out %d, ws %zu); nothing launched\n", n_in, n_in > 0 ? in_sizes[0] : -1, out_size, ws_size); grid = -1; return; }
        int dev = 0, cus = 0, per_cu = 0;
        if (hipGetDevice(&dev) != hipSuccess || hipDeviceGetAttribute(&cus, hipDeviceAttributeMultiprocessorCount, dev) != hipSuccess) { grid = -1; return; }
        if (hipFuncSetAttribute((const void*)layer_fwd, hipFuncAttributeMaxDynamicSharedMemorySize, LDS_BYTES) != hipSuccess) { fprintf(stderr, "kernel_launch: hipFuncSetAttribute failed\n"); grid = -1; return; }
        if (hipOccupancyMaxActiveBlocksPerMultiprocessor(&per_cu, (const void*)layer_fwd, NWAVES * 64, LDS_BYTES) != hipSuccess || per_cu < 1)
            fprintf(stderr, "kernel_launch: note: occupancy query reports %d workgroups per CU\n", per_cu);
        (void)hipGetLastError();
        grid = cus;
    }
    if (grid < 0) return;
    if (hipMemsetAsync((char*)d_ws + WS_CTL, 0, CTL_ZERO_BYTES, stream) != hipSuccess) { fprintf(stderr, "kernel_launch: hipMemsetAsync failed\n"); return; }
    Args a{};
    for (int i = 0; i < 13; ++i) a.in[i] = (const float*)d_in[i];
    a.out = (float*)d_out; a.ws = (unsigned char*)d_ws;
    for (int li = 0; li < N_LAUNCHES; ++li) {
        a.ph_lo = (N_LAUNCHES == 1) ? 0 : li; a.ph_hi = (N_LAUNCHES == 1) ? N_PHASES : li + 1;
        hipLaunchKernelGGL(layer_fwd, dim3(grid), dim3(NWAVES * 64), LDS_BYTES, stream, a);
        const hipError_t le = hipPeekAtLastError();
        if (le != hipSuccess) { fprintf(stderr, "kernel_launch: launch %d failed: %s\n", li, hipGetErrorName(le)); break; }
    }
}
```

```cpp
#include <hip/hip_runtime.h>
#include <cstdio>
#include <cstdint>
namespace pg8 {
#define PG8_LAS __attribute__((address_space(3)))
typedef unsigned short bf16_t;
typedef short bf16x8 __attribute__((ext_vector_type(8)));
typedef float f32x4 __attribute__((ext_vector_type(4)));
typedef unsigned u32x4 __attribute__((ext_vector_type(4)));
constexpr int BM = 256, BK = 64, HALF = 128, HTB = HALF * BK * 2  , STAGE_BYTES = 8 * HTB, NXCD = 8, WGM = 8;

__host__ __device__ __forceinline__ int lds_byte(int r, int c) { const int st = (r >> 4) * 2 + (c >> 5), rr = r & 15, cc = c & 31, ob = rr * 64 + cc * 2; return st * 1024 + (ob ^ (((ob >> 9) & 1) << 5)); }
__host__ __device__ __forceinline__ void stage_rc(int b, int& R, int& C) { const int st = b / 1024, sb = b % 1024, swz = sb ^ (((sb >> 9) & 1) << 5); R = (st >> 1) * 16 + swz / 64; C = (st & 1) * 32 + (swz % 64) / 2; }
__host__ __device__ __forceinline__ int perm32(int rho) { const int n = rho >> 4, i = rho & 15; return 8 * (i >> 2) + 4 * n + (i & 3); }

struct Unit { int pm, pn; };
struct Gemm { const bf16_t* A; const bf16_t* Bt; int M, N, K, lda; };

struct StaticOrder {
    int nM, nN, nwg, G, c;
    __host__ __device__ void init(int M, int N, int G_, int c_) { nM = M / BM; nN = N / BM; nwg = nM * nN; G = G_; c = c_; }
    __host__ __device__ bool next(int i, Unit& u) const {
        const long L = (long)i * G + c; if (L >= nwg) return false;
        int wgid = (int)L; { const int q = nwg / NXCD, r = nwg % NXCD, xcd = wgid % NXCD, off = wgid / NXCD; wgid = (xcd < r ? xcd * (q + 1) : r * (q + 1) + (xcd - r) * q) + off; }
        const int nig = WGM * nN, gid = wgid / nig, fm = gid * WGM, gsz = (nM - fm) < WGM ? (nM - fm) : WGM;
        u.pm = fm + ((wgid % nig) % gsz); u.pn = (wgid % nig) / gsz; return true;
    }
    __device__ __forceinline__ void a_ready(const Unit&) const {}
    __device__ __forceinline__ void done(const Unit&) const {}
};
__device__ __forceinline__ unsigned cvt_pk_bf16(float lo, float hi) { unsigned r; asm volatile("v_cvt_pk_bf16_f32 %0, %1, %2" : "=v"(r) : "v"(lo), "v"(hi)); return r; }
__device__ __forceinline__ float sigmoidf_fast(float x) { return __builtin_amdgcn_rcpf(1.0f + __builtin_amdgcn_exp2f(-1.4426950408889634f * x)); }
__device__ __forceinline__ float bf_lo(unsigned w) { return __uint_as_float(w << 16); }
__device__ __forceinline__ float bf_hi(unsigned w) { return __uint_as_float(w & 0xffff0000u); }

struct EpiF32 {
    static constexpr bool PERM = false, AFTER_DRAIN = false, HAS_MID = false;
    float* C; int ldc; int kmid;
    __device__ __forceinline__ void mid(f32x4 (&)[2][2][4][2], const Unit&, int, int, int, int) const {}
    __device__ __forceinline__ void operator()(const f32x4 (&acc)[2][2][4][2], const Unit& u, int wr, int wc, int fr, int fq) const {
        const int row0 = u.pm * BM + wr * 64 + fr, col0 = u.pn * BM + wc * 32 + 4 * fq;
#pragma unroll
        for (int ai = 0; ai < 2; ++ai)
#pragma unroll
            for (int m = 0; m < 4; ++m) { float* rowp = C + (size_t)(row0 + ai * HALF + m * 16) * ldc + col0;
#pragma unroll
                for (int bj = 0; bj < 2; ++bj)
#pragma unroll
                    for (int n = 0; n < 2; ++n) *(f32x4*)(rowp + bj * HALF + n * 16) = acc[ai][bj][m][n]; }
    }
};
struct EpiProj {
    static constexpr bool PERM = true, AFTER_DRAIN = false, HAS_MID = false;
    bf16_t* QKV; bf16_t* G; int ldq, ldg, nqt, nscale; float qscale; int kmid;
    __device__ __forceinline__ void mid(f32x4 (&)[2][2][4][2], const Unit&, int, int, int, int) const {}
    __device__ __forceinline__ void operator()(const f32x4 (&acc)[2][2][4][2], const Unit& u, int wr, int wc, int fr, int fq) const {
        const int row0 = u.pm * BM + wr * 64 + fr; const bool gate = u.pn >= nqt;
        bf16_t* base = gate ? G : QKV; const int ldc = gate ? ldg : ldq; const int colt = (gate ? (u.pn - nqt) : u.pn) * BM;
        const float sc = (u.pn < nscale) ? qscale : 1.0f;
        const int col0 = colt + wc * 32 + 8 * fq;
#pragma unroll
        for (int ai = 0; ai < 2; ++ai)
#pragma unroll
            for (int m = 0; m < 4; ++m) { bf16_t* rowp = base + (size_t)(row0 + ai * HALF + m * 16) * ldc + col0;
#pragma unroll
                for (int bj = 0; bj < 2; ++bj) { f32x4 v0 = acc[ai][bj][m][0], v1 = acc[ai][bj][m][1];
                    if (gate) {
#pragma unroll
                        for (int j = 0; j < 4; ++j) { v0[j] = sigmoidf_fast(v0[j]); v1[j] = sigmoidf_fast(v1[j]); } }
                    else { v0 = v0 * sc; v1 = v1 * sc; }
                    u32x4 w; w.x = cvt_pk_bf16(v0[0], v0[1]); w.y = cvt_pk_bf16(v0[2], v0[3]); w.z = cvt_pk_bf16(v1[0], v1[1]); w.w = cvt_pk_bf16(v1[2], v1[3]);
                    *(u32x4*)(rowp + bj * HALF) = w; } }
    }
};
struct EpiBranch {
    static constexpr bool PERM = true, AFTER_DRAIN = false, HAS_MID = true;
    bf16_t* O; float* T; const bf16_t* G; int ldc, ldg, goff2; int kmid;
    __device__ __forceinline__ void mid(f32x4 (&acc)[2][2][4][2], const Unit& u, int wr, int wc, int fr, int fq) const {
        unsigned row0 = u.pm * BM + wr * 64 + fr, col0 = u.pn * BM + wc * 32 + 8 * fq;
        asm volatile("" : "+v"(row0), "+v"(col0));
        const char* Gb = (const char*)G; char* Tb = (char*)T;
#pragma unroll
        for (int ai = 0; ai < 2; ++ai)
#pragma unroll
            for (int m = 0; m < 4; ++m) { const unsigned r = row0 + ai * HALF + m * 16; const unsigned go = (r * (unsigned)ldg + col0) * 2u, to = (r * (unsigned)ldc + col0) * 4u;
#pragma unroll
                for (int bj = 0; bj < 2; ++bj) { const u32x4 g = *(const u32x4*)(Gb + (size_t)(go + bj * HALF * 2));
                    f32x4 v0 = acc[ai][bj][m][0], v1 = acc[ai][bj][m][1];
                    v0[0] *= bf_lo(g.x); v0[1] *= bf_hi(g.x); v0[2] *= bf_lo(g.y); v0[3] *= bf_hi(g.y);
                    v1[0] *= bf_lo(g.z); v1[1] *= bf_hi(g.z); v1[2] *= bf_lo(g.w); v1[3] *= bf_hi(g.w);
                    char* tp = Tb + (size_t)(to + bj * HALF * 4); *(f32x4*)tp = v0; *(f32x4*)(tp + 16) = v1;
                    acc[ai][bj][m][0] = (f32x4){0.f, 0.f, 0.f, 0.f}; acc[ai][bj][m][1] = (f32x4){0.f, 0.f, 0.f, 0.f}; }
                asm volatile("" ::: "memory"); }
    }
    __device__ __forceinline__ void operator()(const f32x4 (&acc)[2][2][4][2], const Unit& u, int wr, int wc, int fr, int fq) const {
        const unsigned row0 = u.pm * BM + wr * 64 + fr, col0 = u.pn * BM + wc * 32 + 8 * fq;
        const char* Gb = (const char*)G; const char* Tb = (const char*)T; char* Ob = (char*)O;
#pragma unroll
        for (int ai = 0; ai < 2; ++ai)
#pragma unroll
            for (int m = 0; m < 4; ++m) { const unsigned r = row0 + ai * HALF + m * 16;
                const unsigned go = (r * (unsigned)ldg + goff2 + col0) * 2u, to = (r * (unsigned)ldc + col0) * 4u, oo = (r * (unsigned)ldc + col0) * 2u;
#pragma unroll
                for (int bj = 0; bj < 2; ++bj) { const u32x4 g = *(const u32x4*)(Gb + (size_t)(go + bj * HALF * 2));
                    const char* tp = Tb + (size_t)(to + bj * HALF * 4); const f32x4 t0 = *(const f32x4*)tp, t1 = *(const f32x4*)(tp + 16);
                    f32x4 v0 = acc[ai][bj][m][0], v1 = acc[ai][bj][m][1];
                    v0[0] = t0[0] + v0[0] * bf_lo(g.x); v0[1] = t0[1] + v0[1] * bf_hi(g.x); v0[2] = t0[2] + v0[2] * bf_lo(g.y); v0[3] = t0[3] + v0[3] * bf_hi(g.y);
                    v1[0] = t1[0] + v1[0] * bf_lo(g.z); v1[1] = t1[1] + v1[1] * bf_hi(g.z); v1[2] = t1[2] + v1[2] * bf_lo(g.w); v1[3] = t1[3] + v1[3] * bf_hi(g.w);
                    u32x4 w; w.x = cvt_pk_bf16(v0[0], v0[1]); w.y = cvt_pk_bf16(v0[2], v0[3]); w.z = cvt_pk_bf16(v1[0], v1[1]); w.w = cvt_pk_bf16(v1[2], v1[3]);
                    *(u32x4*)(Ob + (size_t)(oo + bj * HALF * 2)) = w; }
                asm volatile("" ::: "memory"); }
    }
};
struct EpiSwiGLU {
    static constexpr bool PERM = true, AFTER_DRAIN = false, HAS_MID = false;
    bf16_t* O; int ldc; int kmid;
    __device__ __forceinline__ void mid(f32x4 (&)[2][2][4][2], const Unit&, int, int, int, int) const {}
    __device__ __forceinline__ void operator()(const f32x4 (&acc)[2][2][4][2], const Unit& u, int wr, int wc, int fr, int fq) const {
        const int row0 = u.pm * BM + wr * 64 + fr, col0 = u.pn * HALF + wc * 32 + 8 * fq;
#pragma unroll
        for (int ai = 0; ai < 2; ++ai)
#pragma unroll
            for (int m = 0; m < 4; ++m) { bf16_t* rowp = O + (size_t)(row0 + ai * HALF + m * 16) * ldc + col0;
                f32x4 v0, v1;
#pragma unroll
                for (int j = 0; j < 4; ++j) { const float g0 = acc[ai][0][m][0][j], g1 = acc[ai][0][m][1][j];
                    v0[j] = g0 * sigmoidf_fast(g0) * acc[ai][1][m][0][j]; v1[j] = g1 * sigmoidf_fast(g1) * acc[ai][1][m][1][j]; }
                u32x4 w; w.x = cvt_pk_bf16(v0[0], v0[1]); w.y = cvt_pk_bf16(v0[2], v0[3]); w.z = cvt_pk_bf16(v1[0], v1[1]); w.w = cvt_pk_bf16(v1[2], v1[3]);
                *(u32x4*)rowp = w; }
    }
};
template <class Epi, class Sched, bool ALIGN_EPI = false, bool SP2 = false>
__device__ __forceinline__ void gemm_phase(PG8_LAS unsigned char* lds, const Gemm g, const Sched& S, const Epi& E) {
    const int tid = threadIdx.x, wid = __builtin_amdgcn_readfirstlane(tid >> 6), lane = tid & 63, wr = wid >> 2, wc = wid & 3, fr = lane & 15, fq = lane >> 4;
    const int K = g.K, nt = K / BK;
    unsigned voffA[2], voffB[2];
#pragma unroll
    for (int i = 0; i < 2; ++i) { int R, C; stage_rc(tid * 16 + i * 8192, R, C); const int Rb = Epi::PERM ? ((R & ~31) + perm32(R & 31)) : R;
        voffA[i] = (unsigned)(R * g.lda + C) * 2u; voffB[i] = (unsigned)(Rb * K + C) * 2u; }
    const size_t kstep = (size_t)(BK * 2);
    const size_t hstepB = (size_t)HALF * K * 2, hstepA = (size_t)HALF * g.lda * 2;
    const size_t tstepA = 2 * hstepA, tstepB = 2 * hstepB;
    const unsigned ldsw = (unsigned)wid * 1024u;
    const int aoff = lds_byte(wr * 64 + fr, fq * 8), boff = lds_byte(wc * 32 + fr, fq * 8);
#define PG8_SA(b, h) (((b) * 2 + (h)) * HTB)
#define PG8_SB(b, h) ((4 + (b) * 2 + (h)) * HTB)
#define PG8_STAGE(bufoff, gbase, voff) do { _Pragma("unroll") for (int _i = 0; _i < 2; ++_i) \
        __builtin_amdgcn_global_load_lds((const unsigned*)((const char*)(gbase) + (voff)[_i]), (PG8_LAS unsigned*)(lds + (bufoff) + ldsw + _i * 8192), 16, 0, 0); } while (0)
#define PG8_LDA(dst, b, h) do { _Pragma("unroll") for (int m = 0; m < 4; ++m) _Pragma("unroll") for (int k = 0; k < 2; ++k) dst[m][k] = *(const PG8_LAS bf16x8*)(lds + PG8_SA(b, h) + aoff + m * 2048 + k * 1024); } while (0)
#define PG8_LDB(dst, b, h) do { _Pragma("unroll") for (int n = 0; n < 2; ++n) _Pragma("unroll") for (int k = 0; k < 2; ++k) dst[n][k] = *(const PG8_LAS bf16x8*)(lds + PG8_SB(b, h) + boff + n * 2048 + k * 1024); } while (0)
#define PG8_MMA(ai, bj, At, Bt) do { __builtin_amdgcn_s_setprio(1); _Pragma("unroll") for (int m = 0; m < 4; ++m) _Pragma("unroll") for (int n = 0; n < 2; ++n) _Pragma("unroll") for (int k = 0; k < 2; ++k) \
        acc[ai][bj][m][n] = __builtin_amdgcn_mfma_f32_16x16x32_bf16(Bt[n][k], At[m][k], acc[ai][bj][m][n], 0, 0, 0); __builtin_amdgcn_s_setprio(0); } while (0)
#define PG8_WAIT_V(n) asm volatile("s_waitcnt vmcnt(" #n ")" ::: "memory")
#define PG8_WAIT_L(n) asm volatile("s_waitcnt lgkmcnt(" #n ")" ::: "memory")
#define PG8_BAR __builtin_amdgcn_s_barrier()
#define PG8_SCHED __builtin_amdgcn_sched_barrier(0)
    Unit cur, nxt; int ui = 0;
    if (!S.next(0, cur)) return;
    f32x4 acc[2][2][4][2];
#pragma unroll
    for (int a = 0; a < 2; ++a)
#pragma unroll
        for (int b = 0; b < 2; ++b)
#pragma unroll
            for (int m = 0; m < 4; ++m)
#pragma unroll
                for (int n = 0; n < 2; ++n) acc[a][b][m][n] = (f32x4){0.f, 0.f, 0.f, 0.f};
    bf16x8 At[4][2], B0[2][2], B1[2][2];
    const char* cA = (const char*)g.A + (size_t)cur.pm * tstepA; const char* cB = (const char*)g.Bt + (size_t)cur.pn * tstepB;
    S.a_ready(cur);
    if constexpr (SP2) {
        PG8_STAGE(PG8_SB(0, 0), cB, voffB); PG8_STAGE(PG8_SB(0, 1), cB + hstepB, voffB); PG8_STAGE(PG8_SA(0, 0), cA, voffA); PG8_STAGE(PG8_SA(0, 1), cA + hstepA, voffA);
        if (wr == 1) PG8_BAR;
        PG8_WAIT_V(2); PG8_BAR;
        PG8_STAGE(PG8_SB(1, 0), cB + kstep, voffB); PG8_STAGE(PG8_SA(1, 0), cA + kstep, voffA); PG8_STAGE(PG8_SB(1, 1), cB + hstepB + kstep, voffB);
        PG8_WAIT_V(6); PG8_BAR;
    } else {
        PG8_STAGE(PG8_SB(0, 0), cB, voffB); PG8_STAGE(PG8_SA(0, 0), cA, voffA); PG8_STAGE(PG8_SB(0, 1), cB + hstepB, voffB); PG8_STAGE(PG8_SA(0, 1), cA + hstepA, voffA);
        if (wr == 1) PG8_BAR;
        PG8_WAIT_V(4); PG8_BAR;
        PG8_STAGE(PG8_SB(1, 0), cB + kstep, voffB); PG8_STAGE(PG8_SA(1, 0), cA + kstep, voffA); PG8_STAGE(PG8_SB(1, 1), cB + hstepB + kstep, voffB);
        PG8_WAIT_V(6); PG8_BAR;
    }
    for (;;) {
        const bool has_next = S.next(ui + 1, nxt);
        const char* nA = has_next ? (const char*)g.A + (size_t)nxt.pm * tstepA : cA; const char* nB = has_next ? (const char*)g.Bt + (size_t)nxt.pn * tstepB : cB;
        for (int t = 0; t < nt; t += 2) {
            if constexpr (Epi::HAS_MID) { if (t == E.kmid) E.mid(acc, cur, wr, wc, fr, fq); }
            const bool last = (t == nt - 2);
            const char* a1 = cA + (size_t)(t + 1) * kstep;
            const char* a2 = last ? nA : cA + (size_t)(t + 2) * kstep; const char* b2 = last ? nB : cB + (size_t)(t + 2) * kstep;
            const char* a3 = a2 + kstep; const char* b3 = b2 + kstep;
            if (last && has_next) S.a_ready(nxt);
            if constexpr (SP2) {
            PG8_LDB(B0, 0, 0); PG8_LDB(B1, 0, 1); PG8_SCHED; PG8_LDA(At, 0, 0); PG8_STAGE(PG8_SA(1, 1), a1 + hstepA, voffA);
            PG8_WAIT_V(8); PG8_WAIT_L(0); PG8_BAR; PG8_MMA(0, 0, At, B0); PG8_MMA(0, 1, At, B1); PG8_BAR; PG8_SCHED;
            PG8_LDA(At, 0, 1); PG8_STAGE(PG8_SB(0, 0), b2, voffB); PG8_STAGE(PG8_SB(0, 1), b2 + hstepB, voffB); PG8_STAGE(PG8_SA(0, 0), a2, voffA);
            PG8_WAIT_V(8); PG8_WAIT_L(0); PG8_BAR; PG8_MMA(1, 0, At, B0); PG8_MMA(1, 1, At, B1); PG8_BAR; PG8_SCHED;
            PG8_LDB(B0, 1, 0); PG8_LDB(B1, 1, 1); PG8_SCHED; PG8_LDA(At, 1, 0); PG8_STAGE(PG8_SA(0, 1), a2 + hstepA, voffA);
            PG8_WAIT_V(8); PG8_WAIT_L(0); PG8_BAR; PG8_MMA(0, 0, At, B0); PG8_MMA(0, 1, At, B1); PG8_BAR; PG8_SCHED;
            PG8_LDA(At, 1, 1); PG8_STAGE(PG8_SB(1, 0), b3, voffB); PG8_STAGE(PG8_SB(1, 1), b3 + hstepB, voffB); PG8_STAGE(PG8_SA(1, 0), a3, voffA);
            PG8_WAIT_V(8); PG8_WAIT_L(0); PG8_BAR; PG8_MMA(1, 0, At, B0); PG8_MMA(1, 1, At, B1); PG8_BAR; PG8_SCHED;
            } else {
            PG8_LDB(B0, 0, 0); PG8_SCHED; PG8_LDA(At, 0, 0); PG8_STAGE(PG8_SA(1, 1), a1 + hstepA, voffA);
            PG8_WAIT_L(8); PG8_BAR; PG8_WAIT_L(0); PG8_MMA(0, 0, At, B0); PG8_BAR; PG8_SCHED;
            PG8_LDB(B1, 0, 1); PG8_STAGE(PG8_SB(0, 0), b2, voffB);
            PG8_BAR; PG8_WAIT_L(0); PG8_MMA(0, 1, At, B1); PG8_BAR;
            PG8_LDA(At, 0, 1); PG8_STAGE(PG8_SA(0, 0), a2, voffA);
            PG8_BAR; PG8_WAIT_L(0); PG8_MMA(1, 0, At, B0); PG8_BAR; PG8_SCHED;
            PG8_STAGE(PG8_SB(0, 1), b2 + hstepB, voffB);
            PG8_WAIT_V(6); PG8_BAR; PG8_MMA(1, 1, At, B1); PG8_BAR;
            PG8_LDB(B0, 1, 0); PG8_SCHED; PG8_LDA(At, 1, 0); PG8_STAGE(PG8_SA(0, 1), a2 + hstepA, voffA);
            PG8_WAIT_L(8); PG8_BAR; PG8_WAIT_L(0); PG8_MMA(0, 0, At, B0); PG8_BAR; PG8_SCHED;
            PG8_LDB(B1, 1, 1); PG8_STAGE(PG8_SB(1, 0), b3, voffB);
            PG8_BAR; PG8_WAIT_L(0); PG8_MMA(0, 1, At, B1); PG8_BAR;
            PG8_LDA(At, 1, 1); PG8_STAGE(PG8_SA(1, 0), a3, voffA);
            PG8_BAR; PG8_WAIT_L(0); PG8_MMA(1, 0, At, B0); PG8_BAR; PG8_SCHED;
            PG8_STAGE(PG8_SB(1, 1), b3 + hstepB, voffB);
            PG8_WAIT_V(6); PG8_BAR; PG8_MMA(1, 1, At, B1); PG8_BAR;
            }
        }
        if constexpr (ALIGN_EPI) { if (wr == 0) PG8_BAR; }
        if constexpr (!Epi::AFTER_DRAIN) { E(acc, cur, wr, wc, fr, fq); S.done(cur); }
        if (!has_next) break;
#pragma unroll
        for (int a = 0; a < 2; ++a)
#pragma unroll
            for (int b = 0; b < 2; ++b)
#pragma unroll
                for (int m = 0; m < 4; ++m)
#pragma unroll
                    for (int n = 0; n < 2; ++n) acc[a][b][m][n] = (f32x4){0.f, 0.f, 0.f, 0.f};
        cur = nxt; cA = nA; cB = nB; ++ui;
        if constexpr (ALIGN_EPI) { if (wr == 1) PG8_BAR; }
    }
    PG8_WAIT_V(0);
    if constexpr (!ALIGN_EPI) { if (wr == 0) PG8_BAR; }
    PG8_BAR;
    if constexpr (Epi::AFTER_DRAIN) { E.fused(acc, cur, wr, wc, fr, fq, lds, wid, lane); S.done(cur); }
#undef PG8_SA
#undef PG8_SB
#undef PG8_STAGE
#undef PG8_LDA
#undef PG8_LDB
#undef PG8_MMA
#undef PG8_WAIT_V
#undef PG8_WAIT_L
#undef PG8_BAR
#undef PG8_SCHED
}
}
#ifndef PG8_SP2
#define PG8_SP2 true
#endif
constexpr int NWAVES = 8;
#ifndef MK_N_LAUNCHES
#define MK_N_LAUNCHES 1
#endif
constexpr int N_PHASES = 9;
constexpr int N_LAUNCHES = MK_N_LAUNCHES;
static_assert(N_LAUNCHES == 1 || N_LAUNCHES == N_PHASES, "MK_N_LAUNCHES is 1 or 9");

constexpr int BATCH = 8, SEQ = 2048, DM = 2048, NH = 8, HD = 128, DSB = 1024, DIN = 10248, FF = 5632;
constexpr int M = BATCH * SEQ;
constexpr int NPROJ = 10240;
constexpr int NQKV = 6144, NGATE = 4096, NGU = 2 * FF;
constexpr int COL_QSB = 0, COL_QFX = 1024, COL_KSB = 2048, COL_VSB = 3072, COL_KFX = 4096, COL_VFX = 5120;
constexpr float RMS_EPS = 1e-6f;
constexpr float LOG2E = 1.4426950408889634f;
constexpr float QSCALE = 0.08838834764831845f * LOG2E;

constexpr size_t MiB = 1u << 20;
constexpr size_t WS_CTL = 0, CTL_ZERO_BYTES = 1 * MiB;
constexpr size_t WS_WIN = 2 * MiB;
constexpr size_t WS_WBR = 42 * MiB;
constexpr size_t WS_WOUT = 50 * MiB;
constexpr size_t WS_WGU = 58 * MiB;
constexpr size_t WS_WDN = 102 * MiB;
constexpr size_t WS_U = 124 * MiB;
constexpr size_t WS_QKV = 188 * MiB;
constexpr size_t WS_G = 380 * MiB;
constexpr size_t WS_MIX = 188 * MiB;
constexpr size_t WS_HDN = 188 * MiB;
constexpr size_t WS_FFO = 380 * MiB;
constexpr size_t WS_LOGF = 508 * MiB;
constexpr size_t WS_CUM = 508 * MiB + 512 * 1024;
constexpr size_t WS_END = 509 * MiB;
constexpr int CW_TMO = 0, CW_CODE = 1;
constexpr int CW_BAR = 4096;

constexpr int RING_OFF = 0, RING_BYTES = 131072;
constexpr int LDSCTL_OFF = 147456 - 256, MISC_OFF = LDSCTL_OFF + 64;
constexpr int LDS_BYTES = 147456;
static_assert(MISC_OFF + 128 <= LDS_BYTES, "LDS map");
#define GAS __attribute__((address_space(1)))
#define LAS __attribute__((address_space(3)))
typedef unsigned short bf16;
typedef unsigned v4u __attribute__((ext_vector_type(4)));
typedef float f32x4 __attribute__((ext_vector_type(4)));
typedef short bf16x8 __attribute__((ext_vector_type(8)));
typedef GAS unsigned gu32;
typedef GAS unsigned long long gu64;
#define RLX_AGENT __ATOMIC_RELAXED, __HIP_MEMORY_SCOPE_AGENT
#define LDS_WAIT() asm volatile("s_waitcnt lgkmcnt(0)" ::: "memory")
#define VM_WAIT() asm volatile("s_waitcnt vmcnt(0)" ::: "memory")
__device__ __forceinline__ unsigned long long rt() { return __builtin_amdgcn_s_memrealtime(); }
__device__ __forceinline__ unsigned f2bf(float f) { unsigned u = __builtin_bit_cast(unsigned, f); return (u + 0x7fffu + ((u >> 16) & 1u)) >> 16; }
__device__ __forceinline__ unsigned pk2(float lo, float hi) { return f2bf(lo) | (f2bf(hi) << 16); }

#define XB_TMO      128
#define XB_XCNT(j)  (256  + 64 * (j))
#define XB_XSUB(j)  (1280 + 64 * (j))
#define XB_XGEN(j)  (2304 + 64 * (j))
#define XB_TOP      3328
#define XB_TOPGEN   3392
#define XCD_BAR_WORDS 3456
#define XB_SPIN_CAP (1u << 18)

__device__ __forceinline__ unsigned xb_ld(unsigned* p)              { return __hip_atomic_load(p, __ATOMIC_RELAXED, __HIP_MEMORY_SCOPE_AGENT); }
__device__ __forceinline__ unsigned xb_add(unsigned* p, unsigned v) { return __hip_atomic_fetch_add(p, v, __ATOMIC_RELAXED, __HIP_MEMORY_SCOPE_AGENT); }
__device__ __forceinline__ unsigned xb_xcc_id() { return (unsigned)__builtin_amdgcn_s_getreg((3 << 11) | 20) & 0xFu; }
#define XB_SPIN(cond, bar) do { unsigned _sp = 0; while (cond) { __builtin_amdgcn_s_sleep(1); \
    if ((++_sp & 255u) == 0u) { if (xb_ld(&(bar)[XB_TMO])) break; if (_sp > XB_SPIN_CAP) { atomicAdd(&(bar)[XB_TMO], 1u); break; } } } } while (0)

struct XcdBarrier {
    unsigned* bar; unsigned x;
    volatile LAS unsigned* st;
};

__device__ __forceinline__ XcdBarrier xcd_barrier_post(unsigned* bar, volatile LAS unsigned* st) {
    XcdBarrier b; b.bar = bar; b.x = xb_xcc_id(); b.st = st;
    if (threadIdx.x == 0) (void)xb_add(&bar[XB_XCNT(b.x)], 1u);
    return b;
}
__device__ __forceinline__ void xcd_barrier_complete(unsigned* bar, unsigned x, unsigned& nloc, unsigned& nx) {
    const unsigned G = gridDim.x * gridDim.y * gridDim.z;
    unsigned sum, cnt, mine, sp = 0u;
    for (;;) {
        sum = 0u; cnt = 0u; mine = 0u;
#pragma unroll
        for (unsigned j = 0; j < 16; ++j) { const unsigned c = xb_ld(&bar[XB_XCNT(j)]); sum += c; cnt += (c > 0u) ? 1u : 0u; mine = (j == x) ? c : mine; }
        if (sum == G) break;
        __builtin_amdgcn_s_sleep(1);
        if ((++sp & 255u) == 0u) { if (xb_ld(&bar[XB_TMO])) break; if (sp > XB_SPIN_CAP) { atomicAdd(&bar[XB_TMO], 1u); break; } }
    }
    nloc = mine > 0u ? mine : 1u; nx = cnt > 0u ? cnt : 1u;
}

__device__ __forceinline__ void xcd_barrier(const XcdBarrier& b) {
    asm volatile("s_waitcnt vmcnt(0)" ::: "memory");
    __syncthreads();
    if (threadIdx.x == 0) {
        unsigned* bar = b.bar;
        __builtin_amdgcn_s_waitcnt(0);
        unsigned nloc = b.st[0], nx = b.st[1];
        if (nloc == 0u) { xcd_barrier_complete(bar, b.x, nloc, nx); b.st[0] = nloc; b.st[1] = nx; }
        const unsigned old = xb_add(&bar[XB_XSUB(b.x)], 1u);
        const unsigned gen = old / nloc;
        if (old + 1u == (gen + 1u) * nloc) {
            __builtin_amdgcn_fence(__ATOMIC_RELEASE, "agent");
            asm volatile("s_waitcnt vmcnt(0)" ::: "memory");
            const unsigned og = xb_add(&bar[XB_TOP], 1u);
            const unsigned tg = og / nx;
            if (og + 1u == (tg + 1u) * nx) xb_add(&bar[XB_TOPGEN], 1u);
            else XB_SPIN(xb_ld(&bar[XB_TOPGEN]) == tg, bar);
            __builtin_amdgcn_fence(__ATOMIC_ACQUIRE, "agent");
            xb_add(&bar[XB_XGEN(b.x)], 1u);
            asm volatile("s_waitcnt vmcnt(0)" ::: "memory");
        } else {
            XB_SPIN(xb_ld(&bar[XB_XGEN(b.x)]) == gen, bar);
            __builtin_amdgcn_fence(__ATOMIC_ACQUIRE, "agent");
            asm volatile("s_waitcnt vmcnt(0)" ::: "memory");
        }
    }
    __syncthreads();
}
namespace att {
typedef unsigned short bf16;
typedef short bf16x8 __attribute__((ext_vector_type(8)));
typedef _Float16 f16x8 __attribute__((ext_vector_type(8)));
typedef _Float16 f16x2 __attribute__((ext_vector_type(2)));
typedef float f32x2v __attribute__((ext_vector_type(2)));
typedef short s16x4 __attribute__((ext_vector_type(4)));
typedef float f32x16 __attribute__((ext_vector_type(16)));
typedef float f32x4 __attribute__((ext_vector_type(4)));
typedef unsigned u32x4 __attribute__((ext_vector_type(4)));
constexpr int D = 128, PITCH = 6144, SEQ_ = 2048;
constexpr int NW = 8, QBLK = 32, KVBLK = 64, QB = NW * QBLK;
constexpr int SHM_V = KVBLK * D * 2, SHM_K = KVBLK * D * 2;
constexpr int QROWB = 272, QWAVEB = QBLK * QROWB;
constexpr int OFF_WS = 2 * SHM_V + 2 * SHM_K, OFF_BIAS = OFF_WS + NW * 64 * 4, OFF_Q = OFF_BIAS + SEQ_ * 4, LDS_BYTES = OFF_Q + NW * QWAVEB;
constexpr float THR2 = 8.f * 1.4426950408889634f;
constexpr float L2E = 1.4426950408889634f;

#define KSWZ(row, colB) ((row) * 256 + ((colB) ^ (((row) & 7) << 4)))
#define SBAR() __builtin_amdgcn_sched_barrier(0)
__device__ __forceinline__ int v_st(int k, int c) { const int kk = (k & ~0xC) | ((k & 4) << 1) | ((k & 8) >> 1); return ((kk >> 3) * 4 + (c >> 5)) * 512 + ((kk & 7) * 32 + (c & 31)) * 2; }
__device__ __forceinline__ int v_rd_base(int lane) { return ((lane & 3) << 3) | (((lane >> 2) & 3) << 6) | (((lane >> 4) & 1) << 5) | (((lane >> 5) & 1) << 8); }
constexpr int v_rd_off(int d0, int ks, int half) { return d0 * 512 + ks * 4096 + half * 2048; }
__device__ __forceinline__ int crow(int r, int hi) { return (r & 3) + 8 * (r >> 2) + 4 * hi; }
__device__ __forceinline__ unsigned cvtpk(float lo, float hi) { unsigned r; asm volatile("v_cvt_pk_bf16_f32 %0, %1, %2" : "=v"(r) : "v"(lo), "v"(hi)); return r; }
__device__ __forceinline__ bf16x8 load8(const bf16* p) { return *reinterpret_cast<const bf16x8*>(p); }
__device__ __forceinline__ bf16x8 ld16u(const bf16* ubase, unsigned voff) { return *reinterpret_cast<const bf16x8*>((const char*)ubase + (size_t)voff); }

__device__ __forceinline__ void mask_tile(f32x16& p0, f32x16& p1, int dq) {
    const float NEG = -__builtin_inff();
#pragma unroll
    for (int r = 0; r < 16; ++r) { const int c = (r & 3) + 8 * (r >> 2); if (dq - c < 0) p0[r] = NEG; if (dq - c - 32 < 0) p1[r] = NEG; }
}
__device__ __forceinline__ void partialSM(f32x16& p0, f32x16& p1, float& m_reg, float& mn, float& alpha) {
    float pmax = p0[0];
#pragma unroll
    for (int r = 1; r < 16; ++r) pmax = fmaxf(pmax, p0[r]);
#pragma unroll
    for (int r = 0; r < 16; ++r) pmax = fmaxf(pmax, p1[r]);
    { auto rr = __builtin_amdgcn_permlane32_swap(__float_as_uint(pmax), __float_as_uint(pmax), false, false);
      pmax = fmaxf(__uint_as_float(rr[0]), __uint_as_float(rr[1])); }
    if (__builtin_expect(__all((pmax - m_reg) <= THR2), 1)) { mn = m_reg; alpha = 1.f; }
    else { mn = fmaxf(m_reg, pmax); alpha = __builtin_amdgcn_exp2f(m_reg - mn); m_reg = mn; }
#pragma unroll
    for (int r = 0; r < 16; ++r) p0[r] = p0[r] - mn;
#pragma unroll
    for (int r = 0; r < 16; ++r) p1[r] = p1[r] - mn;
#pragma unroll
    for (int r = 0; r < 16; ++r) p0[r] = __builtin_amdgcn_exp2f(p0[r]);
}
#define PK4(P, B_, OUT) do { unsigned a0 = cvtpk(P[B_+0], P[B_+1]), a1 = cvtpk(P[B_+2], P[B_+3]);                          \
        unsigned b0 = cvtpk(P[B_+4], P[B_+5]), b1 = cvtpk(P[B_+6], P[B_+7]);                                             \
        auto r0 = __builtin_amdgcn_permlane32_swap(a0, b0, false, false); auto r1 = __builtin_amdgcn_permlane32_swap(a1, b1, false, false); \
        u32x4 w = {r0[0], r1[0], r0[1], r1[1]}; OUT = *reinterpret_cast<bf16x8*>(&w); } while (0)
__device__ __forceinline__ void finishSM(f32x16& p0, f32x16& p1, float alpha, float& l_reg, bf16x8& pa0, bf16x8& pa1, bf16x8& pa2, bf16x8& pa3) {
#pragma unroll
    for (int r = 0; r < 16; ++r) p1[r] = __builtin_amdgcn_exp2f(p1[r]);
    float ps = 0;
#pragma unroll
    for (int r = 0; r < 16; ++r) ps += p0[r];
#pragma unroll
    for (int r = 0; r < 16; ++r) ps += p1[r];
    { auto rr = __builtin_amdgcn_permlane32_swap(__float_as_uint(ps), __float_as_uint(ps), false, false);
      ps = __uint_as_float(rr[0]) + __uint_as_float(rr[1]); }
    l_reg = l_reg * alpha + ps;
    PK4(p0, 0, pa0); PK4(p0, 8, pa1); PK4(p1, 0, pa2); PK4(p1, 8, pa3);
}
__device__ __forceinline__ void sb_block32(f32x16& X, float& carry, int dqm, bool masked, const f16x8 A0, const f16x8 A1) {
    float L[16];
#pragma unroll
    for (int r = 0; r < 16; ++r) { const float z = X[r];
        const float e = __builtin_amdgcn_exp2f(-__builtin_fabsf(z));
        const float l2 = __builtin_amdgcn_logf(1.0f + e);
        float sp = fmaxf(z, 0.f) + l2;
        float lb = (z - sp) - carry;
        if (masked) { const int c = (r & 3) + 8 * (r >> 2); if (dqm - c < 0) { sp = 0.f; lb = -__builtin_inff(); } }
        L[r] = sp; X[r] = lb; }
    f16x8 b0, b1;
#pragma unroll
    for (int j = 0; j < 8; ++j) { b0[j] = (_Float16)L[j]; b1[j] = (_Float16)L[8 + j]; }
    f32x16 Y = __builtin_amdgcn_mfma_f32_32x32x16_f16(A0, b0, f32x16{}, 0, 0, 0);
    Y = __builtin_amdgcn_mfma_f32_32x32x16_f16(A1, b1, Y, 0, 0, 0);
#pragma unroll
    for (int r = 0; r < 16; ++r) X[r] = X[r] - Y[r];
    const float tot = Y[0] + L[0];
    auto rr = __builtin_amdgcn_permlane32_swap(__float_as_uint(tot), __float_as_uint(tot), false, false);
    carry += __uint_as_float(rr[0]);
}
__device__ __forceinline__ void partialSB(f32x16& p0, f32x16& p1, float& carry, int dq, bool masked, const f16x8 A0, const f16x8 A1) {
    sb_block32(p1, carry, dq - 1 - 32, masked, A0, A1);
    sb_block32(p0, carry, dq - 1, masked, A0, A1);
}
__device__ __forceinline__ void finishSB(f32x16& p0, f32x16& p1, bf16x8& pa0, bf16x8& pa1, bf16x8& pa2, bf16x8& pa3) {
#pragma unroll
    for (int r = 0; r < 16; ++r) p0[r] = __builtin_amdgcn_exp2f(p0[r]);
#pragma unroll
    for (int r = 0; r < 16; ++r) p1[r] = __builtin_amdgcn_exp2f(p1[r]);
    PK4(p0, 0, pa0); PK4(p0, 8, pa1); PK4(p1, 0, pa2); PK4(p1, 8, pa3);
}
template <int KB, bool BIAS>
__device__ __forceinline__ void qkt(f32x16& p0, f32x16& p1, const char* K_lds, int r32, int hi, const char* qbase, const float* bl) {
    if (BIAS) {
#pragma unroll
        for (int g = 0; g < 4; ++g) { const f32x4 a = *reinterpret_cast<const f32x4*>(bl + 8 * g + 4 * hi), b = *reinterpret_cast<const f32x4*>(bl + 32 + 8 * g + 4 * hi);
            p0[4 * g] = a[0]; p0[4 * g + 1] = a[1]; p0[4 * g + 2] = a[2]; p0[4 * g + 3] = a[3];
            p1[4 * g] = b[0]; p1[4 * g + 1] = b[1]; p1[4 * g + 2] = b[2]; p1[4 * g + 3] = b[3]; }
    } else { p0 = f32x16{}; p1 = f32x16{}; }
    const char* kb[4];
#pragma unroll
    for (int dd = 0; dd < 4; ++dd) kb[dd] = K_lds + KB * SHM_K + KSWZ(r32, (dd * 16 + hi * 8) * 2);
#pragma unroll
    for (int d0 = 0; d0 < 8; ++d0) { const char* a = kb[d0 & 3] + (d0 >> 2) * 128;
        bf16x8 b0 = *reinterpret_cast<const bf16x8*>(a);
        bf16x8 b1 = *reinterpret_cast<const bf16x8*>(a + 32 * 256);
        const bf16x8 qf = *reinterpret_cast<const bf16x8*>(qbase + d0 * 32);
        p0 = __builtin_amdgcn_mfma_f32_32x32x16_bf16(b0, qf, p0, 0, 0, 0);
        p1 = __builtin_amdgcn_mfma_f32_32x32x16_bf16(b1, qf, p1, 0, 0, 0); }
}
template <int VB>
__device__ __forceinline__ void pv_tile(f32x16* o, int vb0, bf16x8 pa0, bf16x8 pa1, bf16x8 pa2, bf16x8 pa3) {
#define TRRD(dst, off) asm volatile("ds_read_b64_tr_b16 %0, %1 offset:%2" : "=&v"(dst) : "v"(vb0), "i"(off) : "memory")
#define PV_D0(d0) do { s16x4 l0, l1, l2, l3, h0, h1, h2, h3; constexpr int b_ = VB * SHM_V + v_rd_off(d0, 0, 0); \
        TRRD(l0, b_); TRRD(h0, b_ + 2048); TRRD(l1, b_ + 4096); TRRD(h1, b_ + 6144); TRRD(l2, b_ + 8192); TRRD(h2, b_ + 10240); TRRD(l3, b_ + 12288); TRRD(h3, b_ + 14336); \
        asm volatile("s_waitcnt lgkmcnt(0)" ::: "memory"); SBAR();   \
        o[d0] = __builtin_amdgcn_mfma_f32_32x32x16_bf16(pa0, (bf16x8){l0[0], l0[1], l0[2], l0[3], h0[0], h0[1], h0[2], h0[3]}, o[d0], 0, 0, 0);   \
        o[d0] = __builtin_amdgcn_mfma_f32_32x32x16_bf16(pa1, (bf16x8){l1[0], l1[1], l1[2], l1[3], h1[0], h1[1], h1[2], h1[3]}, o[d0], 0, 0, 0);   \
        o[d0] = __builtin_amdgcn_mfma_f32_32x32x16_bf16(pa2, (bf16x8){l2[0], l2[1], l2[2], l2[3], h2[0], h2[1], h2[2], h2[3]}, o[d0], 0, 0, 0);   \
        o[d0] = __builtin_amdgcn_mfma_f32_32x32x16_bf16(pa3, (bf16x8){l3[0], l3[1], l3[2], l3[3], h3[0], h3[1], h3[2], h3[3]}, o[d0], 0, 0, 0); } while (0)
    PV_D0(0); PV_D0(1); PV_D0(2); PV_D0(3);
#undef PV_D0
#undef TRRD
}

struct BlockRef { const bf16* Q; const bf16* K; const bf16* V; bf16* O; const float* cum; int P0; };
struct Seam { bf16x8 st_v0, st_v1, st_k0, st_k1; };
#define VMW() asm volatile("s_waitcnt vmcnt(0)" ::: "memory")
#define VMWN(n) asm volatile("s_waitcnt vmcnt(%0)" :: "i"(n) : "memory")
#define SLOAD_H(Kp, Vp, k0) do { const bf16* kb_u = (Kp) + (size_t)(k0) * PITCH; const bf16* vb_u = (Vp) + (size_t)(k0) * PITCH;                  \
                         S.st_v0 = ld16u(vb_u, svoff); S.st_v1 = ld16u(vb_u + 32 * PITCH, svoff);              \
                         S.st_k0 = ld16u(kb_u, svoff); S.st_k1 = ld16u(kb_u + 32 * PITCH, svoff); } while (0)
#define SWRITE_HK(bf) do { *(bf16x8*)(K_lds + (bf) * SHM_K + kws) = S.st_k0; *(bf16x8*)(K_lds + (bf) * SHM_K + kws + 32 * 256) = S.st_k1; } while (0)
#define SWRITE_HV(bf) do { *(bf16x8*)(V_lds + (bf) * SHM_V + vst0) = S.st_v0; *(bf16x8*)(V_lds + (bf) * SHM_V + vst0 + vst1d) = S.st_v1; } while (0)
#define SWRITE_H(bf) do { SWRITE_HV(bf); SWRITE_HK(bf); } while (0)
template <bool SB> __device__ __forceinline__ int first_kb(int P0) { return SB ? (P0 / KVBLK + 3) * KVBLK : 0; }
__device__ __forceinline__ void write_bias(const BlockRef& b, char* lds) {
    const int tid = threadIdx.x; float* bl = (float*)(lds + OFF_BIAS);
    if (4 * tid < b.P0 + QB) { const float cref = b.cum[b.P0]; const f32x4 c = *reinterpret_cast<const f32x4*>(b.cum + 4 * tid);
        f32x4 o; o[0] = (cref - c[0]) * L2E; o[1] = (cref - c[1]) * L2E; o[2] = (cref - c[2]) * L2E; o[3] = (cref - c[3]) * L2E;
        *reinterpret_cast<f32x4*>(bl + 4 * tid) = o; }
}
template <bool SB>
__device__ __forceinline__ void attn_prime(const BlockRef& cur, char* lds, Seam& S) {
    const int tid = threadIdx.x, wid = __builtin_amdgcn_readfirstlane(tid >> 6), lane = tid & 63, r32 = lane & 31, hi = lane >> 5;
    const int sr = tid >> 4, sc = (tid & 15) * 8, kws = KSWZ(sr, sc * 2); char* K_lds = lds + 2 * SHM_V;
    const int kb0 = first_kb<SB>(cur.P0);
    const unsigned svoff = (unsigned)((sr * PITCH + sc) * 2), qvoff = (unsigned)((r32 * PITCH + hi * 8) * 2);
    { const bf16* qb_u = cur.Q + (size_t)(wid * QBLK) * PITCH; char* qbase = lds + OFF_Q + wid * QWAVEB + r32 * QROWB + hi * 16;
#pragma unroll
    for (int d0 = 0; d0 < 8; ++d0) *reinterpret_cast<bf16x8*>(qbase + d0 * 32) = ld16u(qb_u + d0 * 16, qvoff); }
    SLOAD_H(cur.K, cur.V, kb0); VMW(); SWRITE_HK(0);
    if (!SB) write_bias(cur, lds);
    __syncthreads();
}
template <bool SB>
__device__ __forceinline__ void attn_block(const BlockRef& cur, const BlockRef& nxt, char* lds, Seam& S, const f16x8 A0, const f16x8 A1) {
    const int tid = threadIdx.x, wid = __builtin_amdgcn_readfirstlane(tid >> 6), lane = tid & 63, r32 = lane & 31, hi = lane >> 5;
    const int NT = cur.P0 / KVBLK + 4;
    const int kbn = first_kb<SB>(nxt.P0);
    const int qlo = cur.P0 + wid * QBLK, qm = qlo + r32 - 4 * hi;
    char* V_lds = lds; char* K_lds = lds + 2 * SHM_V;
    float* ws = (float*)(lds + OFF_WS) + wid * 64; float* li_l = ws, * al_l = ws + 32;
    const float* bl = (const float*)(lds + OFF_BIAS);
    float m_reg = -1e30f, l_reg = 0, carry = 0; f32x16 o[4] = {};
    const int sr = tid >> 4, sc = (tid & 15) * 8, vst0 = v_st(sr, sc), kws = KSWZ(sr, sc * 2); constexpr int vst1d = 8192;
    const int vb0 = (int)(uintptr_t)V_lds + v_rd_base(lane);
    const unsigned svoff = (unsigned)((sr * PITCH + sc) * 2);
    const bf16* Kh = cur.K; const bf16* Vh = cur.V;
    char* qbase = lds + OFF_Q + wid * QWAVEB + r32 * QROWB + hi * 16;
#define RESC(a) do { if (__any((a) < 1.f)) { if (hi == 0) al_l[r32] = (a); asm volatile("s_waitcnt lgkmcnt(0)" ::: "memory");              \
                     for (int d_ = 0; d_ < 4; ++d_) for (int r = 0; r < 16; ++r) o[d_][r] *= al_l[crow(r, hi)]; } } while (0)
#define KBASE(t) ((SB ? (NT - 1 - (t)) : (t)) * KVBLK)
#define NEEDM(t) (KBASE(t) + KVBLK - 1 > qlo - (SB ? 1 : 0))
#define QKT(KB, P0_, P1_, t) qkt<KB, !SB>(P0_, P1_, K_lds, r32, hi, qbase, bl + KBASE(t))
#define PART(P0_, P1_, mnX, alX, t) do { const int kb_ = KBASE(t); if constexpr (SB) { partialSB(P0_, P1_, carry, qm - kb_, NEEDM(t), A0, A1); } \
        else { if (NEEDM(t)) mask_tile(P0_, P1_, qm - kb_); partialSM(P0_, P1_, m_reg, mnX, alX); } } while (0)
#define FIN(P0_, P1_, alY) do { if constexpr (SB) finishSB(P0_, P1_, pa0, pa1, pa2, pa3); else finishSM(P0_, P1_, alY, l_reg, pa0, pa1, pa2, pa3); } while (0)
    constexpr int NQL = 0;
#define SEAM_K0() do { VMWN(NQL); SWRITE_HK(0); SBAR(); } while (0)
    f32x16 pA0, pA1, pB0, pB1; float mnA = 0, mnB = 0, alA = 1.f, alB = 1.f; bf16x8 pa0, pa1, pa2, pa3;
    SWRITE_HV(0); SBAR();
    SLOAD_H(Kh, Vh, KBASE(1));
    SBAR(); QKT(0, pA0, pA1, 0);
    PART(pA0, pA1, mnA, alA, 0);
    VMW(); SWRITE_H(1);
    __syncthreads();
#define HALF_STEP(PX0, PX1, mnX, alX, PY0, PY1, alY, t, KB, VB, SB_) do {                                                      \
        SBAR(); QKT(KB, PX0, PX1, t);                                                                                          \
        FIN(PY0, PY1, alY); SBAR();                                                                                            \
        if ((t) + 1 < NT) { SLOAD_H(Kh, Vh, KBASE((t) + 1)); SBAR(); }                                                         \
        pv_tile<VB>(o, vb0, pa0, pa1, pa2, pa3); PART(PX0, PX1, mnX, alX, t);                                                   \
        __syncthreads();                                                                                                       \
        if ((t) + 1 < NT) { VMW(); SWRITE_H(SB_); }                                                                            \
        if constexpr (!SB) RESC(alX);                                                                                          \
        __syncthreads(); } while (0)
    for (int t = 1; t + 1 < NT; t += 2) {
        HALF_STEP(pB0, pB1, mnB, alB, pA0, pA1, alA, t, 1, 0, 0);
        HALF_STEP(pA0, pA1, mnA, alA, pB0, pB1, alB, t + 1, 0, 1, 1);
    }
    SBAR(); QKT(1, pB0, pB1, NT - 1); SBAR();
    SLOAD_H(nxt.K, nxt.V, kbn); SBAR();
    FIN(pA0, pA1, alA); SBAR();
    pv_tile<0>(o, vb0, pa0, pa1, pa2, pa3);
    PART(pB0, pB1, mnB, alB, NT - 1); __syncthreads();
    if constexpr (!SB) RESC(alB);
    FIN(pB0, pB1, alB); SBAR(); pv_tile<1>(o, vb0, pa0, pa1, pa2, pa3);
    SBAR(); SEAM_K0();
    float rli[16];
    if constexpr (!SB) { if (hi == 0) li_l[r32] = l_reg; asm volatile("s_waitcnt lgkmcnt(0)" ::: "memory");
#pragma unroll
        for (int r = 0; r < 16; ++r) rli[r] = __builtin_amdgcn_rcpf(li_l[crow(r, hi)]); }
    else {
#pragma unroll
        for (int r = 0; r < 16; ++r) rli[r] = 1.f; }
    bf16* Ow = cur.O + (size_t)(wid * QBLK) * PITCH;
    int lane_e = lane; asm volatile("" : "+v"(lane_e));
    const int r32e = lane_e & 31, hie = lane_e >> 5;
    const unsigned ovoff = (unsigned)((4 * hie * PITCH + r32e) * 2), qvoff = (unsigned)((r32e * PITCH + hie * 8) * 2);
#pragma unroll
    for (int r = 0; r < 16; ++r) { const int orow0 = (r & 3) + 8 * (r >> 2);
#pragma unroll
        for (int d0 = 0; d0 < 4; ++d0) { const float v = o[d0][r] * rli[r];
            const float vn = __shfl_xor(v, 1);
            if ((r32e & 1) == 0) *(unsigned*)((char*)(Ow + (size_t)orow0 * PITCH + d0 * 32) + (size_t)ovoff) = cvtpk(v, vn); } }
    if constexpr (!SB) write_bias(nxt, lds);
    { const bf16* qb_u = nxt.Q + (size_t)(wid * QBLK) * PITCH;
#pragma unroll
    for (int d0 = 0; d0 < 8; ++d0) *reinterpret_cast<bf16x8*>(qbase + d0 * 32) = ld16u(qb_u + d0 * 16, qvoff); }
    __syncthreads();
#undef RESC
#undef KBASE
#undef NEEDM
#undef QKT
#undef PART
#undef FIN
#undef SEAM_K0
#undef HALF_STEP
}
#undef VMW
#undef VMWN
#undef SLOAD_H
#undef SWRITE_HK
#undef SWRITE_HV
#undef SWRITE_H
#undef PK4
#undef KSWZ
#undef SBAR

__device__ __forceinline__ void scan_consts(f16x8& A0, f16x8& A1) {
    const int lane = threadIdx.x & 63, i = lane & 31, h = lane >> 5;
#pragma unroll
    for (int j = 0; j < 8; ++j) { const int k0 = 8 * (j >> 2) + 4 * h + (j & 3), k1 = 16 + k0;
        A0[j] = (k0 > i) ? (_Float16)1.0f : (_Float16)0.0f; A1[j] = (k1 > i) ? (_Float16)1.0f : (_Float16)0.0f; }
}
__device__ __forceinline__ void attn_phase(char* lds, bf16* QKV, const float* CUM, int v, int G) {
    for (int item = v; item < 256; item += G) {
        const int bh = item >> 2, p = item & 3, b = bh >> 3, h = bh & 7;
        bf16* base = QKV + (size_t)b * SEQ_ * PITCH;
        const float* cum = CUM + (size_t)bh * SEQ_;
#ifndef NO_SB
        { f16x8 A0, A1; scan_consts(A0, A1); Seam S; BlockRef c0, c1;
          c0.K = base + 2048 + h * D; c0.V = base + 3072 + h * D; c0.cum = cum; c1 = c0;
          c0.P0 = (7 - p) * QB; c0.Q = base + (size_t)c0.P0 * PITCH + h * D; c0.O = (bf16*)c0.Q;
          c1.P0 = p * QB; c1.Q = base + (size_t)c1.P0 * PITCH + h * D; c1.O = (bf16*)c1.Q;
          attn_prime<true>(c0, lds, S); attn_block<true>(c0, c1, lds, S, A0, A1); attn_block<true>(c1, c1, lds, S, A0, A1); }
#endif
#ifndef NO_FOX
        { const f16x8 A0 = {}, A1 = {}; Seam S; BlockRef c0, c1;
          c0.K = base + 4096 + h * D; c0.V = base + 5120 + h * D; c0.cum = cum; c1 = c0;
          c0.P0 = (7 - p) * QB; c0.Q = base + (size_t)c0.P0 * PITCH + 1024 + h * D; c0.O = (bf16*)c0.Q;
          c1.P0 = p * QB; c1.Q = base + (size_t)c1.P0 * PITCH + 1024 + h * D; c1.O = (bf16*)c1.Q;
          attn_prime<false>(c0, lds, S); attn_block<false>(c0, c1, lds, S, A0, A1); attn_block<false>(c1, c1, lds, S, A0, A1); }
#endif
    }
}
}
struct Frame {
    LAS unsigned char* lds;
    volatile LAS unsigned* MISC;
    gu32* ctl;
    int tid, lane, wave;
    int vcu, G;
    const float* x; float* out;
    const float *g_mix_pre, *g_mix_post, *w_in, *b_forget, *w_bsb, *w_bfx, *w_out, *g_ffn_pre, *g_ffn_post, *w_gate, *w_up, *w_down;
    bf16 *Win_t, *Wbr_t, *Wout_t, *Wgu_t, *Wdn_t;
    bf16 *U, *QKV, *GT, *HDN;
    float *MIX, *FFO, *LOGF, *CUM;
};

__device__ __forceinline__ float wave_sum(float v) {
#pragma unroll
    for (int o = 1; o < 64; o <<= 1) v += __shfl_xor(v, o);
    return v;
}
__device__ __forceinline__ void tr_item(const float* W, int Npitch, int ncol0, bf16* WT, int dpitch, int drow0, int dk0, LAS float* scr, int kb, int lane) {
    const int k0 = 64 * kb;
#pragma unroll 8
    for (int i = 0; i < 32; ++i) { const int kk = 2 * i + (lane >> 5); scr[kk * 33 + (lane & 31)] = W[(size_t)(k0 + kk) * Npitch + ncol0 + (lane & 31)]; }
    LDS_WAIT(); asm volatile("" ::: "memory");
    const int c = lane & 7;
#pragma unroll
    for (int j = 0; j < 4; ++j) { const int n = (lane >> 3) + 8 * j; const LAS float* s = scr + (8 * c) * 33 + n;
        v4u o; o.x = pk2(s[0 * 33], s[1 * 33]); o.y = pk2(s[2 * 33], s[3 * 33]); o.z = pk2(s[4 * 33], s[5 * 33]); o.w = pk2(s[6 * 33], s[7 * 33]);
        *(GAS v4u*)(WT + (size_t)(drow0 + n) * dpitch + dk0 + k0 + 8 * c) = o; }
    LDS_WAIT(); asm volatile("" ::: "memory");
}
struct Seg { const float* W; int K, Npitch, n0, ncols; bf16* WT; int dpitch, drow0, dk0, rowmode; };
__device__ __forceinline__ int seg_items(const Seg& s) { return (s.K / 64) * (s.ncols / 32); }
__device__ __forceinline__ void seg_item(const Seg& s, int item, LAS float* scr, int lane) {
    const int nblk = s.ncols / 32, kb = item / nblk, nb = item % nblk, n = 32 * nb;
    int drow = s.drow0 + n;
    if (s.rowmode) drow = 256 * (n >> 7) + (n & 127) + (s.rowmode == 2 ? 128 : 0);
    tr_item(s.W, s.Npitch, s.n0 + n, s.WT, s.dpitch, drow, s.dk0, scr, kb, lane);
}

__device__ __forceinline__ void p0_prologue(Frame& F) {
    LAS float* scr = (LAS float*)(F.lds + RING_OFF + F.wave * 16384);
    const int gw = F.vcu * NWAVES + F.wave, NGW = F.G * NWAVES;
    {
        const Seg segs[11] = {
            {F.w_in, DM, DIN, 0, 1024, F.Win_t, DM, 0, 0, 0},
            {F.w_in, DM, DIN, 1024, 2048, F.Win_t, DM, 2048, 0, 0},
            {F.w_in, DM, DIN, 3072, 1024, F.Win_t, DM, 1024, 0, 0},
            {F.w_in, DM, DIN, 4096, 2048, F.Win_t, DM, 4096, 0, 0},
            {F.w_in, DM, DIN, 6152, 4096, F.Win_t, DM, 6144, 0, 0},
            {F.w_bsb, DSB, DM, 0, DM, F.Wbr_t, 2 * DSB, 0, 0, 0},
            {F.w_bfx, DSB, DM, 0, DM, F.Wbr_t, 2 * DSB, 0, DSB, 0},
            {F.w_out, DM, DM, 0, DM, F.Wout_t, DM, 0, 0, 0},
            {F.w_gate, DM, FF, 0, FF, F.Wgu_t, DM, 0, 0, 1},
            {F.w_up, DM, FF, 0, FF, F.Wgu_t, DM, 0, 0, 2},
            {F.w_down, FF, DM, 0, DM, F.Wdn_t, FF, 0, 0, 0},
        };
        int base = 0;
#pragma unroll
        for (int si = 0; si < 11; ++si) {
            const int ni = seg_items(segs[si]);
            int first = (gw - (base % NGW) + NGW) % NGW;
            for (int it = first; it < ni; it += NGW) seg_item(segs[si], it, scr, F.lane);
            base += ni;
        }
    }
    __syncthreads();
    LAS float* Wf = (LAS float*)(F.lds + RING_OFF);
    for (int k = F.tid; k < DM; k += NWAVES * 64) {
        const float g = F.g_mix_pre[k];
        const f32x4 a = *(const GAS f32x4*)(F.w_in + (size_t)k * DIN + 6144), b = *(const GAS f32x4*)(F.w_in + (size_t)k * DIN + 6148);
        Wf[0 * DM + k] = g * a.x; Wf[1 * DM + k] = g * a.y; Wf[2 * DM + k] = g * a.z; Wf[3 * DM + k] = g * a.w;
        Wf[4 * DM + k] = g * b.x; Wf[5 * DM + k] = g * b.y; Wf[6 * DM + k] = g * b.z; Wf[7 * DM + k] = g * b.w;
    }
    __syncthreads();
    const float bfh = F.b_forget[F.lane & 7];
    for (int m = gw; m < M; m += NGW) {
        const GAS f32x4* xr = (const GAS f32x4*)(F.x + (size_t)m * DM) + F.lane;
        f32x4 v[8]; float s = 0.f;
#pragma unroll
        for (int j = 0; j < 8; ++j) { v[j] = xr[64 * j]; s += (v[j].x * v[j].x + v[j].y * v[j].y) + (v[j].z * v[j].z + v[j].w * v[j].w); }
        const float rstd = 1.0f / sqrtf(wave_sum(s) * (1.f / DM) + RMS_EPS);
        float mine = 0.f;
#pragma unroll 1
        for (int h = 0; h < 8; ++h) { float a = 0.f;
#pragma unroll
            for (int j = 0; j < 8; ++j) { const f32x4 w = *(const LAS f32x4*)(Wf + h * DM + 256 * j + 4 * F.lane); a += (v[j].x * w.x + v[j].y * w.y) + (v[j].z * w.z + v[j].w * w.w); }
            const float t = wave_sum(a); if ((F.lane & 7) == h) mine = t; }
        GAS unsigned long long* o8 = (GAS unsigned long long*)(F.U + (size_t)m * DM) + F.lane;
#pragma unroll
        for (int j = 0; j < 8; ++j) { const f32x4 gj = ((const GAS f32x4*)F.g_mix_pre)[64 * j + F.lane]; const f32x4 u = v[j] * rstd * gj;
            o8[64 * j] = (unsigned long long)pk2(u.x, u.y) | ((unsigned long long)pk2(u.z, u.w) << 32); }
        if (F.lane < 8) { const float y = mine * rstd + bfh;
            F.LOGF[(size_t)m * 8 + F.lane] = -(fmaxf(-y, 0.f) + log1pf(expf(-fabsf(y)))); }
    }
}

__device__ __forceinline__ void cumsum_step(Frame& F) {
    if (F.vcu < BATCH * NH) {
        const int bh = F.vcu, b = bh / NH, h = bh % NH;
        LAS float* part = (LAS float*)(F.lds + RING_OFF);
        float v[4]; float run = 0.f;
#pragma unroll
        for (int i = 0; i < 4; ++i) { run += F.LOGF[(size_t)(b * SEQ + 4 * F.tid + i) * 8 + h]; v[i] = run; }
        float inc = run;
#pragma unroll
        for (int o = 1; o < 64; o <<= 1) { const float t = __shfl_up(inc, o); if (F.lane >= o) inc += t; }
        if (F.lane == 63) part[F.wave] = inc;
        __syncthreads();
        float woff = 0.f;
        for (int w = 0; w < F.wave; ++w) woff += part[w];
        const float off = woff + inc - run;
#pragma unroll
        for (int i = 0; i < 4; ++i) F.CUM[(size_t)bh * SEQ + 4 * F.tid + i] = off + v[i];
    }
    __syncthreads();
}

#if defined(NAIVE_ATTN)
__device__ __forceinline__ void unpack8(const v4u w, float* f) {
    f[0] = __uint_as_float(w.x << 16); f[1] = __uint_as_float(w.x & 0xffff0000u); f[2] = __uint_as_float(w.y << 16); f[3] = __uint_as_float(w.y & 0xffff0000u);
    f[4] = __uint_as_float(w.z << 16); f[5] = __uint_as_float(w.z & 0xffff0000u); f[6] = __uint_as_float(w.w << 16); f[7] = __uint_as_float(w.w & 0xffff0000u);
}
__device__ __forceinline__ void naive_attn_item(Frame& F, int br, int b, int h, int qb) {
    LAS bf16* Ks = (LAS bf16*)(F.lds + RING_OFF); LAS bf16* Vs = Ks + 64 * HD;
    const int row = F.tid >> 2, part = F.tid & 3, t = qb * 128 + row;
    const size_t grow = (size_t)(b * SEQ + t);
    const bf16* qp = F.QKV + grow * NQKV + (br ? COL_QFX : COL_QSB) + h * HD + part * 32;
    float q[32], o[32];
#pragma unroll
    for (int c = 0; c < 4; ++c) { unpack8(*(const GAS v4u*)(qp + 8 * c), q + 8 * c); }
#pragma unroll
    for (int i = 0; i < 32; ++i) o[i] = 0.f;
    const int kcol = (br ? COL_KFX : COL_KSB) + h * HD, vcol = (br ? COL_VFX : COL_VSB) + h * HD;
    const float* cum = F.CUM + (size_t)(b * NH + h) * SEQ;
    const float cq = br ? cum[t] * LOG2E : 0.f;
    float mrun = -1e30f, lrun = 0.f, carry = 0.f;
    const int NT = (qb * 128 + 128) / 64;
    for (int it = 0; it < NT; ++it) {
        const int jt = br ? it : NT - 1 - it;
        __syncthreads();
#pragma unroll
        for (int i = 0; i < 2; ++i) { const int idx = F.tid + 512 * i, r = idx >> 4, c = (idx & 15) * 8; const size_t gr = (size_t)(b * SEQ + jt * 64 + r) * NQKV;
            *(LAS v4u*)(Ks + r * HD + c) = *(const GAS v4u*)(F.QKV + gr + kcol + c); *(LAS v4u*)(Vs + r * HD + c) = *(const GAS v4u*)(F.QKV + gr + vcol + c); }
        __syncthreads();
        for (int kk = 0; kk < 64; ++kk) {
            const int si = br ? kk : 63 - kk, s = jt * 64 + si;
            float d = 0.f; float kf[8];
#pragma unroll
            for (int c = 0; c < 4; ++c) { unpack8(*(const LAS v4u*)(Ks + si * HD + part * 32 + 8 * c), kf);
#pragma unroll
                for (int e = 0; e < 8; ++e) d += q[8 * c + e] * kf[e]; }
            d += __shfl_xor(d, 1); d += __shfl_xor(d, 2);
            float wgt = 0.f, alpha = 1.f;
            if (br) {
                if (s <= t) { const float logit = d + cq - cum[s] * LOG2E; const float mn = fmaxf(mrun, logit);
                    alpha = exp2f(mrun - mn); wgt = exp2f(logit - mn); lrun = lrun * alpha + wgt; mrun = mn; }
            } else {
                if (s < t) { const float e = exp2f(-fabsf(d)); const float l2 = log2f(1.0f + e); const float sp = fmaxf(d, 0.f) + l2;
                    wgt = exp2f((d - sp) - carry); carry += sp; }
            }
#pragma unroll
            for (int c = 0; c < 4; ++c) { unpack8(*(const LAS v4u*)(Vs + si * HD + part * 32 + 8 * c), kf);
#pragma unroll
                for (int e = 0; e < 8; ++e) o[8 * c + e] = o[8 * c + e] * alpha + wgt * kf[e]; }
        }
    }
    const float inv = br ? 1.0f / lrun : 1.0f;
    bf16* op = F.QKV + grow * NQKV + (br ? 1024 : 0) + h * HD + part * 32;
#pragma unroll
    for (int c = 0; c < 4; ++c) { v4u w; w.x = pk2(o[8 * c] * inv, o[8 * c + 1] * inv); w.y = pk2(o[8 * c + 2] * inv, o[8 * c + 3] * inv);
        w.z = pk2(o[8 * c + 4] * inv, o[8 * c + 5] * inv); w.w = pk2(o[8 * c + 6] * inv, o[8 * c + 7] * inv); *(GAS v4u*)(op + 8 * c) = w; }
}
__device__ __forceinline__ void naive_attn_phase(Frame& F) {
    for (int i = blockIdx.x; i < 16 * 128; i += F.G) { const int qb = i >> 7, br = (i >> 6) & 1, bh = i & 63; naive_attn_item(F, br, bh / NH, bh % NH, qb); }
    __syncthreads();
}

#endif
__device__ __forceinline__ void p5_rows(Frame& F) {
    const int gw = F.vcu * NWAVES + F.wave, NGW = F.G * NWAVES;
    for (int m = gw; m < M; m += NGW) {
        const GAS f32x4* mr = (const GAS f32x4*)(F.MIX + (size_t)m * DM) + F.lane;
        const GAS f32x4* xr = (const GAS f32x4*)(F.x + (size_t)m * DM) + F.lane;
        f32x4 v[8], xv[8]; float s = 0.f;
#pragma unroll
        for (int j = 0; j < 8; ++j) { v[j] = mr[64 * j]; xv[j] = xr[64 * j]; s += (v[j].x * v[j].x + v[j].y * v[j].y) + (v[j].z * v[j].z + v[j].w * v[j].w); }
        const float rstd = 1.0f / sqrtf(wave_sum(s) * (1.f / DM) + RMS_EPS);
        float s2 = 0.f;
        GAS f32x4* orow = (GAS f32x4*)(F.out + (size_t)m * DM) + F.lane;
#pragma unroll
        for (int j = 0; j < 8; ++j) { const f32x4 g = ((const GAS f32x4*)F.g_mix_post)[64 * j + F.lane]; const f32x4 hh = xv[j] + v[j] * rstd * g; v[j] = hh; orow[64 * j] = hh;
            s2 += (hh.x * hh.x + hh.y * hh.y) + (hh.z * hh.z + hh.w * hh.w); }
        const float rstd2 = 1.0f / sqrtf(wave_sum(s2) * (1.f / DM) + RMS_EPS);
        GAS unsigned long long* o8 = (GAS unsigned long long*)(F.U + (size_t)m * DM) + F.lane;
#pragma unroll
        for (int j = 0; j < 8; ++j) { const f32x4 g = ((const GAS f32x4*)F.g_ffn_pre)[64 * j + F.lane]; const f32x4 u = v[j] * rstd2 * g;
            o8[64 * j] = (unsigned long long)pk2(u.x, u.y) | ((unsigned long long)pk2(u.z, u.w) << 32); }
    }
}
__device__ __forceinline__ void p8_rows(Frame& F) {
    const int gw = F.vcu * NWAVES + F.wave, NGW = F.G * NWAVES;
    for (int m = gw; m < M; m += NGW) {
        const GAS f32x4* fr = (const GAS f32x4*)(F.FFO + (size_t)m * DM) + F.lane;
        GAS f32x4* orow = (GAS f32x4*)(F.out + (size_t)m * DM) + F.lane;
        f32x4 v[8], hv[8]; float s = 0.f;
#pragma unroll
        for (int j = 0; j < 8; ++j) { v[j] = fr[64 * j]; hv[j] = orow[64 * j]; s += (v[j].x * v[j].x + v[j].y * v[j].y) + (v[j].z * v[j].z + v[j].w * v[j].w); }
        const float rstd = 1.0f / sqrtf(wave_sum(s) * (1.f / DM) + RMS_EPS);
#pragma unroll
        for (int j = 0; j < 8; ++j) { const f32x4 g = ((const GAS f32x4*)F.g_ffn_post)[64 * j + F.lane]; orow[64 * j] = hv[j] + v[j] * rstd * g; }
    }
}

struct Args { const float* in[13]; float* out; unsigned char* ws; int ph_lo, ph_hi; };
__global__ void __launch_bounds__(NWAVES * 64, 2) layer_fwd(Args args) {
    extern __shared__ __attribute__((aligned(16))) unsigned char lds[];
    Frame F;
    F.lds = (LAS unsigned char*)lds;
    F.MISC = (volatile LAS unsigned*)(F.lds + MISC_OFF);
    F.tid = threadIdx.x; F.lane = F.tid & 63; F.wave = __builtin_amdgcn_readfirstlane(F.tid >> 6);
    F.G = gridDim.x; { const int bx = blockIdx.x; F.vcu = (F.G % 8 == 0) ? (bx % 8) * (F.G / 8) + bx / 8 : bx; }
    unsigned char* ws = args.ws;
    F.ctl = (gu32*)(ws + WS_CTL);
    F.x = args.in[0]; F.g_mix_pre = args.in[1]; F.g_mix_post = args.in[2]; F.w_in = args.in[3]; F.b_forget = args.in[4]; F.w_bsb = args.in[5]; F.w_bfx = args.in[6];
    F.w_out = args.in[7]; F.g_ffn_pre = args.in[8]; F.g_ffn_post = args.in[9]; F.w_gate = args.in[10]; F.w_up = args.in[11]; F.w_down = args.in[12]; F.out = args.out;
    F.Win_t = (bf16*)(ws + WS_WIN); F.Wbr_t = (bf16*)(ws + WS_WBR); F.Wout_t = (bf16*)(ws + WS_WOUT); F.Wgu_t = (bf16*)(ws + WS_WGU); F.Wdn_t = (bf16*)(ws + WS_WDN);
    F.U = (bf16*)(ws + WS_U); F.QKV = (bf16*)(ws + WS_QKV); F.GT = (bf16*)(ws + WS_G); F.HDN = (bf16*)(ws + WS_HDN);
    F.MIX = (float*)(ws + WS_MIX); F.FFO = (float*)(ws + WS_FFO); F.LOGF = (float*)(ws + WS_LOGF); F.CUM = (float*)(ws + WS_CUM);
    for (int u = F.tid; u < (LDS_BYTES - LDSCTL_OFF) / 4; u += NWAVES * 64) ((LAS unsigned*)(F.lds + LDSCTL_OFF))[u] = 0u;
    __syncthreads();
    XcdBarrier bar; bar.bar = (unsigned*)(F.ctl + CW_BAR); bar.x = 0; bar.st = nullptr;
    if (N_LAUNCHES == 1) bar = xcd_barrier_post((unsigned*)(F.ctl + CW_BAR), F.MISC + 8);
#define GRID_BAR() do { if (N_LAUNCHES == 1) xcd_barrier(bar); } while (0)
    const int lo = args.ph_lo, hi = args.ph_hi;
#ifndef PH_MASK
#define PH_MASK 0x1ff
#endif
#define IN(k) (((PH_MASK >> (k)) & 1) && lo <= (k) && (k) < hi)
#define BOTH(k) (IN(k) && IN((k) + 1))

    if (IN(0)) { p0_prologue(F); if (BOTH(0)) GRID_BAR(); }
    if (IN(1)) {
        cumsum_step(F);
        pg8::Gemm g{F.U, F.Win_t, M, NPROJ, DM, DM}; pg8::StaticOrder S; S.init(M, NPROJ, F.G, (int)blockIdx.x);
        pg8::EpiProj E{F.QKV, F.GT, NQKV, NGATE, NQKV / 256, 2048 / 256, QSCALE, 0};
        pg8::gemm_phase<pg8::EpiProj, pg8::StaticOrder, true, true>(F.lds + RING_OFF, g, S, E);
        if (BOTH(1)) GRID_BAR();
    }
#if defined(NAIVE_ATTN)
    if (IN(2)) { naive_attn_phase(F); if (BOTH(2)) GRID_BAR(); }
#else
    if (IN(2)) { att::attn_phase((char*)lds + RING_OFF, F.QKV, F.CUM, F.vcu, F.G); if (BOTH(2)) GRID_BAR(); }
#endif
    if (IN(3)) {
        pg8::Gemm g{F.QKV, F.Wbr_t, M, DM, 2 * DSB, NQKV}; pg8::StaticOrder S; S.init(M, DM, F.G, (int)blockIdx.x);
        pg8::EpiBranch E{F.U, F.out, F.GT, DM, NGATE, DM, DSB / 64};
        pg8::gemm_phase<pg8::EpiBranch, pg8::StaticOrder, true, true>(F.lds + RING_OFF, g, S, E);
        if (BOTH(3)) GRID_BAR();
    }
    if (IN(4)) {
        pg8::Gemm g{F.U, F.Wout_t, M, DM, DM, DM}; pg8::StaticOrder S; S.init(M, DM, F.G, (int)blockIdx.x);
        pg8::EpiF32 E{F.MIX, DM, 0};
        pg8::gemm_phase<pg8::EpiF32, pg8::StaticOrder, true, true>(F.lds + RING_OFF, g, S, E);
        if (BOTH(4)) GRID_BAR();
    }
    if (IN(5)) { p5_rows(F); if (BOTH(5)) GRID_BAR(); }
    if (IN(6)) {
        pg8::Gemm g{F.U, F.Wgu_t, M, NGU, DM, DM}; pg8::StaticOrder S; S.init(M, NGU, F.G, (int)blockIdx.x);
        pg8::EpiSwiGLU E{F.HDN, FF, 0};
        pg8::gemm_phase<pg8::EpiSwiGLU, pg8::StaticOrder, true, true>(F.lds + RING_OFF, g, S, E);
        if (BOTH(6)) GRID_BAR();
    }
    if (IN(7)) {
        pg8::Gemm g{F.HDN, F.Wdn_t, M, DM, FF, FF}; pg8::StaticOrder S; S.init(M, DM, F.G, (int)blockIdx.x);
        pg8::EpiF32 E{F.FFO, DM, 0};
        pg8::gemm_phase<pg8::EpiF32, pg8::StaticOrder, true, true>(F.lds + RING_OFF, g, S, E);
        if (BOTH(7)) GRID_BAR();
    }
    if (IN(8)) { p8_rows(F); }
#undef IN
#undef BOTH
}

extern "C" void kernel_launch(void* const* d_in, const int* in_sizes, int n_in, void* d_out, int out_size, void* d_ws, size_t ws_size, hipStream_t stream) {
    static int grid = 0;
    if (grid == 0) {
        if (n_in != 13 || in_sizes[0] != M * DM || out_size != M * DM || ws_size < WS_END) {
            fprintf(stderr, "kernel_launch: unexpected shapes (n_in %d, in0 %d, out %d, ws %zu); nothing launched\n", n_in, n_in > 0 ? in_sizes[0] : -1, out_size, ws_size); grid = -1; return; }
        int dev = 0, cus = 0, per_cu = 0;
        if (hipGetDevice(&dev) != hipSuccess || hipDeviceGetAttribute(&cus, hipDeviceAttributeMultiprocessorCount, dev) != hipSuccess) { grid = -1; return; }
        if (hipFuncSetAttribute((const void*)layer_fwd, hipFuncAttributeMaxDynamicSharedMemorySize, LDS_BYTES) != hipSuccess) { fprintf(stderr, "kernel_launch: hipFuncSetAttribute failed\n"); grid = -1; return; }
        if (hipOccupancyMaxActiveBlocksPerMultiprocessor(&per_cu, (const void*)layer_fwd, NWAVES * 64, LDS_BYTES) != hipSuccess || per_cu < 1)
            fprintf(stderr, "kernel_launch: note: occupancy query reports %d workgroups per CU\n", per_cu);
        (void)hipGetLastError();
        grid = cus;
    }
    if (grid < 0) return;
    if (hipMemsetAsync((char*)d_ws + WS_CTL, 0, CTL_ZERO_BYTES, stream) != hipSuccess) { fprintf(stderr, "kernel_launch: hipMemsetAsync failed\n"); return; }
    Args a{};
    for (int i = 0; i < 13; ++i) a.in[i] = (const float*)d_in[i];
    a.out = (float*)d_out; a.ws = (unsigned char*)d_ws;
    for (int li = 0; li < N_LAUNCHES; ++li) {
        a.ph_lo = (N_LAUNCHES == 1) ? 0 : li; a.ph_hi = (N_LAUNCHES == 1) ? N_PHASES : li + 1;
        hipLaunchKernelGGL(layer_fwd, dim3(grid), dim3(NWAVES * 64), LDS_BYTES, stream, a);
        const hipError_t le = hipPeekAtLastError();
        if (le != hipSuccess) { fprintf(stderr, "kernel_launch: launch %d failed: %s\n", li, hipGetErrorName(le)); break; }
    }
}
```

```cpp
#include <hip/hip_runtime.h>
#include <cstdio>
#include <cstdint>
namespace pg8 {
#define PG8_LAS __attribute__((address_space(3)))
typedef unsigned short bf16_t;
typedef short bf16x8 __attribute__((ext_vector_type(8)));
typedef float f32x4 __attribute__((ext_vector_type(4)));
typedef unsigned u32x4 __attribute__((ext_vector_type(4)));
constexpr int BM = 256, BK = 64, HALF = 128, HTB = HALF * BK * 2  , STAGE_BYTES = 8 * HTB, NXCD = 8, WGM = 8;

__host__ __device__ __forceinline__ int lds_byte(int r, int c) { const int st = (r >> 4) * 2 + (c >> 5), rr = r & 15, cc = c & 31, ob = rr * 64 + cc * 2; return st * 1024 + (ob ^ (((ob >> 9) & 1) << 5)); }
__host__ __device__ __forceinline__ void stage_rc(int b, int& R, int& C) { const int st = b / 1024, sb = b % 1024, swz = sb ^ (((sb >> 9) & 1) << 5); R = (st >> 1) * 16 + swz / 64; C = (st & 1) * 32 + (swz % 64) / 2; }
__host__ __device__ __forceinline__ int perm32(int rho) { const int n = rho >> 4, i = rho & 15; return 8 * (i >> 2) + 4 * n + (i & 3); }

struct Unit { int pm, pn; };
struct Gemm { const bf16_t* A; const bf16_t* Bt; int M, N, K, lda; };

struct StaticOrder {
    int nM, nN, nwg, G, c;
    __host__ __device__ void init(int M, int N, int G_, int c_) { nM = M / BM; nN = N / BM; nwg = nM * nN; G = G_; c = c_; }
    __host__ __device__ bool next(int i, Unit& u) const {
        const long L = (long)i * G + c; if (L >= nwg) return false;
        int wgid = (int)L; { const int q = nwg / NXCD, r = nwg % NXCD, xcd = wgid % NXCD, off = wgid / NXCD; wgid = (xcd < r ? xcd * (q + 1) : r * (q + 1) + (xcd - r) * q) + off; }
        const int nig = WGM * nN, gid = wgid / nig, fm = gid * WGM, gsz = (nM - fm) < WGM ? (nM - fm) : WGM;
        u.pm = fm + ((wgid % nig) % gsz); u.pn = (wgid % nig) / gsz; return true;
    }
    __device__ __forceinline__ void a_ready(const Unit&) const {}
    __device__ __forceinline__ void done(const Unit&) const {}
};
__device__ __forceinline__ unsigned cvt_pk_bf16(float lo, float hi) { unsigned r; asm volatile("v_cvt_pk_bf16_f32 %0, %1, %2" : "=v"(r) : "v"(lo), "v"(hi)); return r; }
#ifndef EPI2_MASK
#define EPI2_MASK 0
#endif
__device__ __forceinline__ float sigmoidf_fast(float x) { return __builtin_amdgcn_rcpf(1.0f + __builtin_amdgcn_exp2f(-1.4426950408889634f * x)); }
__device__ __forceinline__ float bf_lo(unsigned w) { return __uint_as_float(w << 16); }
__device__ __forceinline__ float bf_hi(unsigned w) { return __uint_as_float(w & 0xffff0000u); }

struct EpiF32 {
    static constexpr bool TWICE = (EPI2_MASK & 0) != 0;
    static constexpr bool PERM = false, AFTER_DRAIN = false, HAS_MID = false;
    float* C; int ldc; int kmid;
    __device__ __forceinline__ void mid(f32x4 (&)[2][2][4][2], const Unit&, int, int, int, int) const {}
    __device__ __forceinline__ void operator()(const f32x4 (&acc)[2][2][4][2], const Unit& u, int wr, int wc, int fr, int fq) const {
        const int row0 = u.pm * BM + wr * 64 + fr, col0 = u.pn * BM + wc * 32 + 4 * fq;
#pragma unroll
        for (int ai = 0; ai < 2; ++ai)
#pragma unroll
            for (int m = 0; m < 4; ++m) { float* rowp = C + (size_t)(row0 + ai * HALF + m * 16) * ldc + col0;
#pragma unroll
                for (int bj = 0; bj < 2; ++bj)
#pragma unroll
                    for (int n = 0; n < 2; ++n) *(f32x4*)(rowp + bj * HALF + n * 16) = acc[ai][bj][m][n]; }
    }
};
struct EpiBf16 {
    static constexpr bool TWICE = (EPI2_MASK & 144) != 0;
    static constexpr bool PERM = true, AFTER_DRAIN = false, HAS_MID = false;
    bf16_t* O; int ldc; int kmid;
    __device__ __forceinline__ void mid(f32x4 (&)[2][2][4][2], const Unit&, int, int, int, int) const {}
    __device__ __forceinline__ void operator()(const f32x4 (&acc)[2][2][4][2], const Unit& u, int wr, int wc, int fr, int fq) const {
        const int row0 = u.pm * BM + wr * 64 + fr, col0 = u.pn * BM + wc * 32 + 8 * fq;
#pragma unroll
        for (int ai = 0; ai < 2; ++ai)
#pragma unroll
            for (int m = 0; m < 4; ++m) { bf16_t* rowp = O + (size_t)(row0 + ai * HALF + m * 16) * ldc + col0;
#pragma unroll
                for (int bj = 0; bj < 2; ++bj) { const f32x4 v0 = acc[ai][bj][m][0], v1 = acc[ai][bj][m][1];
                    u32x4 w; w.x = cvt_pk_bf16(v0[0], v0[1]); w.y = cvt_pk_bf16(v0[2], v0[3]); w.z = cvt_pk_bf16(v1[0], v1[1]); w.w = cvt_pk_bf16(v1[2], v1[3]);
                    *(u32x4*)(rowp + bj * HALF) = w; } }
    }
};
struct EpiProj {
    static constexpr bool TWICE = (EPI2_MASK & 2) != 0;
    static constexpr bool PERM = true, AFTER_DRAIN = false, HAS_MID = false;
    bf16_t* QKV; bf16_t* G; int ldq, ldg, nqt, nscale; float qscale; int kmid;
    __device__ __forceinline__ void mid(f32x4 (&)[2][2][4][2], const Unit&, int, int, int, int) const {}
    __device__ __forceinline__ void operator()(const f32x4 (&acc)[2][2][4][2], const Unit& u, int wr, int wc, int fr, int fq) const {
        const int row0 = u.pm * BM + wr * 64 + fr; const bool gate = u.pn >= nqt;
        bf16_t* base = gate ? G : QKV; const int ldc = gate ? ldg : ldq; const int colt = (gate ? (u.pn - nqt) : u.pn) * BM;
        const float sc = (u.pn < nscale) ? qscale : 1.0f;
        const int col0 = colt + wc * 32 + 8 * fq;
#pragma unroll
        for (int ai = 0; ai < 2; ++ai)
#pragma unroll
            for (int m = 0; m < 4; ++m) { bf16_t* rowp = base + (size_t)(row0 + ai * HALF + m * 16) * ldc + col0;
#pragma unroll
                for (int bj = 0; bj < 2; ++bj) { f32x4 v0 = acc[ai][bj][m][0], v1 = acc[ai][bj][m][1];
                    if (gate) {
#pragma unroll
                        for (int j = 0; j < 4; ++j) { v0[j] = sigmoidf_fast(v0[j]); v1[j] = sigmoidf_fast(v1[j]); } }
                    else { v0 = v0 * sc; v1 = v1 * sc; }
                    u32x4 w; w.x = cvt_pk_bf16(v0[0], v0[1]); w.y = cvt_pk_bf16(v0[2], v0[3]); w.z = cvt_pk_bf16(v1[0], v1[1]); w.w = cvt_pk_bf16(v1[2], v1[3]);
                    *(u32x4*)(rowp + bj * HALF) = w; } }
    }
};
struct EpiBranch {
    static constexpr bool TWICE = (EPI2_MASK & 8) != 0;
    static constexpr bool PERM = true, AFTER_DRAIN = false, HAS_MID = true;
    bf16_t* O; const bf16_t* G; int ldc, ldg, goff2; int kmid;
    static __device__ __forceinline__ float rg(float g1, float g2) { return g1 * __builtin_amdgcn_rcpf(fmaxf(g2, 1e-20f)); }
    __device__ __forceinline__ void mid(f32x4 (&acc)[2][2][4][2], const Unit& u, int wr, int wc, int fr, int fq) const {
        unsigned row0 = u.pm * BM + wr * 64 + fr, col0 = u.pn * BM + wc * 32 + 8 * fq;
        asm volatile("" : "+v"(row0), "+v"(col0));
        const char* Gb = (const char*)G;
#pragma unroll
        for (int ai = 0; ai < 2; ++ai) {
            u32x4 g[4][2], h[4][2];
#pragma unroll
            for (int m = 0; m < 4; ++m) { const unsigned r = row0 + ai * HALF + m * 16; const unsigned go = (r * (unsigned)ldg + col0) * 2u;
#pragma unroll
                for (int bj = 0; bj < 2; ++bj) { g[m][bj] = *(const u32x4*)(Gb + (size_t)(go + bj * HALF * 2)); h[m][bj] = *(const u32x4*)(Gb + (size_t)(go + (goff2 + bj * HALF) * 2)); } }
#pragma unroll
            for (int m = 0; m < 4; ++m)
#pragma unroll
                for (int bj = 0; bj < 2; ++bj) { const u32x4 gg = g[m][bj], hh = h[m][bj];
                    f32x4 v0 = acc[ai][bj][m][0], v1 = acc[ai][bj][m][1];
                    v0[0] *= rg(bf_lo(gg.x), bf_lo(hh.x)); v0[1] *= rg(bf_hi(gg.x), bf_hi(hh.x)); v0[2] *= rg(bf_lo(gg.y), bf_lo(hh.y)); v0[3] *= rg(bf_hi(gg.y), bf_hi(hh.y));
                    v1[0] *= rg(bf_lo(gg.z), bf_lo(hh.z)); v1[1] *= rg(bf_hi(gg.z), bf_hi(hh.z)); v1[2] *= rg(bf_lo(gg.w), bf_lo(hh.w)); v1[3] *= rg(bf_hi(gg.w), bf_hi(hh.w));
                    acc[ai][bj][m][0] = v0; acc[ai][bj][m][1] = v1; }
            asm volatile("" ::: "memory"); }
    }
    __device__ __forceinline__ void operator()(const f32x4 (&acc)[2][2][4][2], const Unit& u, int wr, int wc, int fr, int fq) const {
        const unsigned row0 = u.pm * BM + wr * 64 + fr, col0 = u.pn * BM + wc * 32 + 8 * fq;
        const char* Gb = (const char*)G; char* Ob = (char*)O;
        u32x4 g[2][4][2];
#pragma unroll
        for (int ai = 0; ai < 2; ++ai)
#pragma unroll
            for (int m = 0; m < 4; ++m) { const unsigned r = row0 + ai * HALF + m * 16; const unsigned go = (r * (unsigned)ldg + goff2 + col0) * 2u;
#pragma unroll
                for (int bj = 0; bj < 2; ++bj) g[ai][m][bj] = *(const u32x4*)(Gb + (size_t)(go + bj * HALF * 2)); }
#pragma unroll
        for (int ai = 0; ai < 2; ++ai)
#pragma unroll
            for (int m = 0; m < 4; ++m) { const unsigned r = row0 + ai * HALF + m * 16; const unsigned oo = (r * (unsigned)ldc + col0) * 2u;
#pragma unroll
                for (int bj = 0; bj < 2; ++bj) { const u32x4 gg = g[ai][m][bj];
                    f32x4 v0 = acc[ai][bj][m][0], v1 = acc[ai][bj][m][1];
                    v0[0] *= fmaxf(bf_lo(gg.x), 1e-20f); v0[1] *= fmaxf(bf_hi(gg.x), 1e-20f); v0[2] *= fmaxf(bf_lo(gg.y), 1e-20f); v0[3] *= fmaxf(bf_hi(gg.y), 1e-20f);
                    v1[0] *= fmaxf(bf_lo(gg.z), 1e-20f); v1[1] *= fmaxf(bf_hi(gg.z), 1e-20f); v1[2] *= fmaxf(bf_lo(gg.w), 1e-20f); v1[3] *= fmaxf(bf_hi(gg.w), 1e-20f);
                    u32x4 w; w.x = cvt_pk_bf16(v0[0], v0[1]); w.y = cvt_pk_bf16(v0[2], v0[3]); w.z = cvt_pk_bf16(v1[0], v1[1]); w.w = cvt_pk_bf16(v1[2], v1[3]);
                    *(u32x4*)(Ob + (size_t)(oo + bj * HALF * 2)) = w; } }
    }
};
struct EpiSwiGLU {
    static constexpr bool TWICE = (EPI2_MASK & 64) != 0;
    static constexpr bool PERM = true, AFTER_DRAIN = false, HAS_MID = false;
    bf16_t* O; int ldc; int kmid;
    __device__ __forceinline__ void mid(f32x4 (&)[2][2][4][2], const Unit&, int, int, int, int) const {}
    __device__ __forceinline__ void operator()(const f32x4 (&acc)[2][2][4][2], const Unit& u, int wr, int wc, int fr, int fq) const {
        const int row0 = u.pm * BM + wr * 64 + fr, col0 = u.pn * HALF + wc * 32 + 8 * fq;
#pragma unroll
        for (int ai = 0; ai < 2; ++ai)
#pragma unroll
            for (int m = 0; m < 4; ++m) { bf16_t* rowp = O + (size_t)(row0 + ai * HALF + m * 16) * ldc + col0;
                f32x4 v0, v1;
#pragma unroll
                for (int j = 0; j < 4; ++j) { const float g0 = acc[ai][0][m][0][j], g1 = acc[ai][0][m][1][j];
                    v0[j] = g0 * sigmoidf_fast(g0) * acc[ai][1][m][0][j]; v1[j] = g1 * sigmoidf_fast(g1) * acc[ai][1][m][1][j]; }
                u32x4 w; w.x = cvt_pk_bf16(v0[0], v0[1]); w.y = cvt_pk_bf16(v0[2], v0[3]); w.z = cvt_pk_bf16(v1[0], v1[1]); w.w = cvt_pk_bf16(v1[2], v1[3]);
                *(u32x4*)rowp = w; }
    }
};
template <class Epi, class Sched, bool ALIGN_EPI = false, bool SP2 = false>
__device__ __forceinline__ void gemm_phase(PG8_LAS unsigned char* lds, const Gemm g, const Sched& S, const Epi& E) {
    const int tid = threadIdx.x, wid = __builtin_amdgcn_readfirstlane(tid >> 6), lane = tid & 63, wr = wid >> 2, wc = wid & 3, fr = lane & 15, fq = lane >> 4;
    const int K = g.K, nt = K / BK;
    unsigned voffA[2], voffB[2];
#pragma unroll
    for (int i = 0; i < 2; ++i) { int R, C; stage_rc(tid * 16 + i * 8192, R, C); const int Rb = Epi::PERM ? ((R & ~31) + perm32(R & 31)) : R;
        voffA[i] = (unsigned)(R * g.lda + C) * 2u; voffB[i] = (unsigned)(Rb * K + C) * 2u; }
    const size_t kstep = (size_t)(BK * 2);
    const size_t hstepB = (size_t)HALF * K * 2, hstepA = (size_t)HALF * g.lda * 2;
    const size_t tstepA = 2 * hstepA, tstepB = 2 * hstepB;
    const unsigned ldsw = (unsigned)wid * 1024u;
    const int aoff = lds_byte(wr * 64 + fr, fq * 8), boff = lds_byte(wc * 32 + fr, fq * 8);
#define PG8_SA(b, h) (((b) * 2 + (h)) * HTB)
#define PG8_SB(b, h) ((4 + (b) * 2 + (h)) * HTB)
#define PG8_STAGE(bufoff, gbase, voff) do { _Pragma("unroll") for (int _i = 0; _i < 2; ++_i) \
        __builtin_amdgcn_global_load_lds((const unsigned*)((const char*)(gbase) + (voff)[_i]), (PG8_LAS unsigned*)(lds + (bufoff) + ldsw + _i * 8192), 16, 0, 0); } while (0)
#define PG8_LDA(dst, b, h) do { _Pragma("unroll") for (int m = 0; m < 4; ++m) _Pragma("unroll") for (int k = 0; k < 2; ++k) dst[m][k] = *(const PG8_LAS bf16x8*)(lds + PG8_SA(b, h) + aoff + m * 2048 + k * 1024); } while (0)
#define PG8_LDB(dst, b, h) do { _Pragma("unroll") for (int n = 0; n < 2; ++n) _Pragma("unroll") for (int k = 0; k < 2; ++k) dst[n][k] = *(const PG8_LAS bf16x8*)(lds + PG8_SB(b, h) + boff + n * 2048 + k * 1024); } while (0)
#define PG8_MMA(ai, bj, At, Bt) do { __builtin_amdgcn_s_setprio(1); _Pragma("unroll") for (int m = 0; m < 4; ++m) _Pragma("unroll") for (int n = 0; n < 2; ++n) _Pragma("unroll") for (int k = 0; k < 2; ++k) \
        acc[ai][bj][m][n] = __builtin_amdgcn_mfma_f32_16x16x32_bf16(Bt[n][k], At[m][k], acc[ai][bj][m][n], 0, 0, 0); __builtin_amdgcn_s_setprio(0); } while (0)
#define PG8_WAIT_V(n) asm volatile("s_waitcnt vmcnt(" #n ")" ::: "memory")
#define PG8_WAIT_L(n) asm volatile("s_waitcnt lgkmcnt(" #n ")" ::: "memory")
#define PG8_BAR __builtin_amdgcn_s_barrier()
#define PG8_SCHED __builtin_amdgcn_sched_barrier(0)
    Unit cur, nxt; int ui = 0;
    if (!S.next(0, cur)) return;
    f32x4 acc[2][2][4][2];
#pragma unroll
    for (int a = 0; a < 2; ++a)
#pragma unroll
        for (int b = 0; b < 2; ++b)
#pragma unroll
            for (int m = 0; m < 4; ++m)
#pragma unroll
                for (int n = 0; n < 2; ++n) acc[a][b][m][n] = (f32x4){0.f, 0.f, 0.f, 0.f};
    bf16x8 At[4][2], B0[2][2], B1[2][2];
    const char* cA = (const char*)g.A + (size_t)cur.pm * tstepA; const char* cB = (const char*)g.Bt + (size_t)cur.pn * tstepB;
    S.a_ready(cur);
    if constexpr (SP2) {
        PG8_STAGE(PG8_SB(0, 0), cB, voffB); PG8_STAGE(PG8_SB(0, 1), cB + hstepB, voffB); PG8_STAGE(PG8_SA(0, 0), cA, voffA); PG8_STAGE(PG8_SA(0, 1), cA + hstepA, voffA);
        if (wr == 1) PG8_BAR;
        PG8_WAIT_V(2); PG8_BAR;
        PG8_STAGE(PG8_SB(1, 0), cB + kstep, voffB); PG8_STAGE(PG8_SA(1, 0), cA + kstep, voffA); PG8_STAGE(PG8_SB(1, 1), cB + hstepB + kstep, voffB);
        PG8_WAIT_V(6); PG8_BAR;
    } else {
        PG8_STAGE(PG8_SB(0, 0), cB, voffB); PG8_STAGE(PG8_SA(0, 0), cA, voffA); PG8_STAGE(PG8_SB(0, 1), cB + hstepB, voffB); PG8_STAGE(PG8_SA(0, 1), cA + hstepA, voffA);
        if (wr == 1) PG8_BAR;
        PG8_WAIT_V(4); PG8_BAR;
        PG8_STAGE(PG8_SB(1, 0), cB + kstep, voffB); PG8_STAGE(PG8_SA(1, 0), cA + kstep, voffA); PG8_STAGE(PG8_SB(1, 1), cB + hstepB + kstep, voffB);
        PG8_WAIT_V(6); PG8_BAR;
    }
    for (;;) {
        const bool has_next = S.next(ui + 1, nxt);
        const char* nA = has_next ? (const char*)g.A + (size_t)nxt.pm * tstepA : cA; const char* nB = has_next ? (const char*)g.Bt + (size_t)nxt.pn * tstepB : cB;
        for (int t = 0; t < nt; t += 2) {
            if constexpr (Epi::HAS_MID) { if (t == E.kmid) E.mid(acc, cur, wr, wc, fr, fq); }
            const bool last = (t == nt - 2);
            const char* a1 = cA + (size_t)(t + 1) * kstep;
            const char* a2 = last ? nA : cA + (size_t)(t + 2) * kstep; const char* b2 = last ? nB : cB + (size_t)(t + 2) * kstep;
            const char* a3 = a2 + kstep; const char* b3 = b2 + kstep;
            if (last && has_next) S.a_ready(nxt);
            if constexpr (SP2) {
            PG8_LDB(B0, 0, 0); PG8_LDB(B1, 0, 1); PG8_SCHED; PG8_LDA(At, 0, 0); PG8_STAGE(PG8_SA(1, 1), a1 + hstepA, voffA);
            PG8_WAIT_V(8); PG8_WAIT_L(0); PG8_BAR; PG8_MMA(0, 0, At, B0); PG8_MMA(0, 1, At, B1); PG8_BAR; PG8_SCHED;
            PG8_LDA(At, 0, 1); PG8_STAGE(PG8_SB(0, 0), b2, voffB); PG8_STAGE(PG8_SB(0, 1), b2 + hstepB, voffB); PG8_STAGE(PG8_SA(0, 0), a2, voffA);
            PG8_WAIT_V(8); PG8_WAIT_L(0); PG8_BAR; PG8_MMA(1, 0, At, B0); PG8_MMA(1, 1, At, B1); PG8_BAR; PG8_SCHED;
            PG8_LDB(B0, 1, 0); PG8_LDB(B1, 1, 1); PG8_SCHED; PG8_LDA(At, 1, 0); PG8_STAGE(PG8_SA(0, 1), a2 + hstepA, voffA);
            PG8_WAIT_V(8); PG8_WAIT_L(0); PG8_BAR; PG8_MMA(0, 0, At, B0); PG8_MMA(0, 1, At, B1); PG8_BAR; PG8_SCHED;
            PG8_LDA(At, 1, 1); PG8_STAGE(PG8_SB(1, 0), b3, voffB); PG8_STAGE(PG8_SB(1, 1), b3 + hstepB, voffB); PG8_STAGE(PG8_SA(1, 0), a3, voffA);
            PG8_WAIT_V(8); PG8_WAIT_L(0); PG8_BAR; PG8_MMA(1, 0, At, B0); PG8_MMA(1, 1, At, B1); PG8_BAR; PG8_SCHED;
            } else {
            PG8_LDB(B0, 0, 0); PG8_SCHED; PG8_LDA(At, 0, 0); PG8_STAGE(PG8_SA(1, 1), a1 + hstepA, voffA);
            PG8_WAIT_L(8); PG8_BAR; PG8_WAIT_L(0); PG8_MMA(0, 0, At, B0); PG8_BAR; PG8_SCHED;
            PG8_LDB(B1, 0, 1); PG8_STAGE(PG8_SB(0, 0), b2, voffB);
            PG8_BAR; PG8_WAIT_L(0); PG8_MMA(0, 1, At, B1); PG8_BAR;
            PG8_LDA(At, 0, 1); PG8_STAGE(PG8_SA(0, 0), a2, voffA);
            PG8_BAR; PG8_WAIT_L(0); PG8_MMA(1, 0, At, B0); PG8_BAR; PG8_SCHED;
            PG8_STAGE(PG8_SB(0, 1), b2 + hstepB, voffB);
            PG8_WAIT_V(6); PG8_BAR; PG8_MMA(1, 1, At, B1); PG8_BAR;
            PG8_LDB(B0, 1, 0); PG8_SCHED; PG8_LDA(At, 1, 0); PG8_STAGE(PG8_SA(0, 1), a2 + hstepA, voffA);
            PG8_WAIT_L(8); PG8_BAR; PG8_WAIT_L(0); PG8_MMA(0, 0, At, B0); PG8_BAR; PG8_SCHED;
            PG8_LDB(B1, 1, 1); PG8_STAGE(PG8_SB(1, 0), b3, voffB);
            PG8_BAR; PG8_WAIT_L(0); PG8_MMA(0, 1, At, B1); PG8_BAR;
            PG8_LDA(At, 1, 1); PG8_STAGE(PG8_SA(1, 0), a3, voffA);
            PG8_BAR; PG8_WAIT_L(0); PG8_MMA(1, 0, At, B0); PG8_BAR; PG8_SCHED;
            PG8_STAGE(PG8_SB(1, 1), b3 + hstepB, voffB);
            PG8_WAIT_V(6); PG8_BAR; PG8_MMA(1, 1, At, B1); PG8_BAR;
            }
        }
        if constexpr (ALIGN_EPI) { if (wr == 0) PG8_BAR; }
        if constexpr (!Epi::AFTER_DRAIN) { E(acc, cur, wr, wc, fr, fq); if constexpr (Epi::TWICE) { asm volatile("" ::: "memory"); E(acc, cur, wr, wc, fr, fq); } S.done(cur); }
        if (!has_next) break;
#pragma unroll
        for (int a = 0; a < 2; ++a)
#pragma unroll
            for (int b = 0; b < 2; ++b)
#pragma unroll
                for (int m = 0; m < 4; ++m)
#pragma unroll
                    for (int n = 0; n < 2; ++n) acc[a][b][m][n] = (f32x4){0.f, 0.f, 0.f, 0.f};
        cur = nxt; cA = nA; cB = nB; ++ui;
        if constexpr (ALIGN_EPI) { if (wr == 1) PG8_BAR; }
    }
    PG8_WAIT_V(0);
    if constexpr (!ALIGN_EPI) { if (wr == 0) PG8_BAR; }
    PG8_BAR;
    if constexpr (Epi::AFTER_DRAIN) { E.fused(acc, cur, wr, wc, fr, fq, lds, wid, lane); S.done(cur); }
#undef PG8_SA
#undef PG8_SB
#undef PG8_STAGE
#undef PG8_LDA
#undef PG8_LDB
#undef PG8_MMA
#undef PG8_WAIT_V
#undef PG8_WAIT_L
#undef PG8_BAR
#undef PG8_SCHED
}
}
#ifndef PG8_SP2
#define PG8_SP2 true
#endif
#ifndef PG8_ALIGN
#define PG8_ALIGN true
#endif
constexpr int NWAVES = 8;
#ifndef MK_N_LAUNCHES
#define MK_N_LAUNCHES 1
#endif
constexpr int N_PHASES = 9;
constexpr int N_LAUNCHES = MK_N_LAUNCHES;
static_assert(N_LAUNCHES == 1 || N_LAUNCHES == N_PHASES, "MK_N_LAUNCHES is 1 or 9");

constexpr int BATCH = 8, SEQ = 2048, DM = 2048, NH = 8, HD = 128, DSB = 1024, DIN = 10248, FF = 5632;
constexpr int M = BATCH * SEQ;
constexpr int NPROJ = 10240;
constexpr int NQKV = 6144, NGATE = 4096, NGU = 2 * FF;
constexpr int COL_QSB = 0, COL_QFX = 1024, COL_KSB = 2048, COL_VSB = 3072, COL_KFX = 4096, COL_VFX = 5120;
constexpr float RMS_EPS = 1e-6f;
constexpr float LOG2E = 1.4426950408889634f;
constexpr float QSCALE = 0.08838834764831845f * LOG2E;

constexpr size_t MiB = 1u << 20;
constexpr size_t WS_CTL = 0, CTL_ZERO_BYTES = 1 * MiB;
constexpr size_t WS_WIN = 2 * MiB;
constexpr size_t WS_WBR = 42 * MiB;
constexpr size_t WS_WOUT = 50 * MiB;
constexpr size_t WS_WGU = 58 * MiB;
constexpr size_t WS_WDN = 102 * MiB;
constexpr size_t WS_U = 124 * MiB;
constexpr size_t WS_QKV = 188 * MiB;
constexpr size_t WS_G = 380 * MiB;
constexpr size_t WS_MIX = 188 * MiB;
constexpr size_t WS_HDN = 188 * MiB;
constexpr size_t WS_FFO = 380 * MiB;
constexpr size_t WS_LOGF = 508 * MiB;
constexpr size_t WS_CUM = 508 * MiB + 512 * 1024;
constexpr size_t WS_END = 509 * MiB;
constexpr int CW_TMO = 0, CW_CODE = 1;
constexpr int CW_BAR = 4096;

constexpr int RING_OFF = 0, RING_BYTES = 131072;
constexpr int LDSCTL_OFF = 147456 - 256, MISC_OFF = LDSCTL_OFF + 64;
constexpr int LDS_BYTES = 147456;
static_assert(MISC_OFF + 128 <= LDS_BYTES, "LDS map");
#define GAS __attribute__((address_space(1)))
#define LAS __attribute__((address_space(3)))
typedef unsigned short bf16;
typedef unsigned v4u __attribute__((ext_vector_type(4)));
typedef float f32x4 __attribute__((ext_vector_type(4)));
typedef short bf16x8 __attribute__((ext_vector_type(8)));
typedef GAS unsigned gu32;
typedef GAS unsigned long long gu64;
#define RLX_AGENT __ATOMIC_RELAXED, __HIP_MEMORY_SCOPE_AGENT
#define LDS_WAIT() asm volatile("s_waitcnt lgkmcnt(0)" ::: "memory")
#define VM_WAIT() asm volatile("s_waitcnt vmcnt(0)" ::: "memory")
__device__ __forceinline__ unsigned long long rt() { return __builtin_amdgcn_s_memrealtime(); }
__device__ __forceinline__ unsigned f2bf(float f) { unsigned u = __builtin_bit_cast(unsigned, f); return (u + 0x7fffu + ((u >> 16) & 1u)) >> 16; }
__device__ __forceinline__ unsigned pk2(float lo, float hi) { return f2bf(lo) | (f2bf(hi) << 16); }

#define XB_TMO      128
#define XB_XCNT(j)  (256  + 64 * (j))
#define XB_XSUB(j)  (1280 + 64 * (j))
#define XB_XGEN(j)  (2304 + 64 * (j))
#define XB_TOP      3328
#define XB_TOPGEN   3392
#define XCD_BAR_WORDS 3456
#define XB_SPIN_CAP (1u << 18)

__device__ __forceinline__ unsigned xb_ld(unsigned* p)              { return __hip_atomic_load(p, __ATOMIC_RELAXED, __HIP_MEMORY_SCOPE_AGENT); }
__device__ __forceinline__ unsigned xb_add(unsigned* p, unsigned v) { return __hip_atomic_fetch_add(p, v, __ATOMIC_RELAXED, __HIP_MEMORY_SCOPE_AGENT); }
__device__ __forceinline__ unsigned xb_xcc_id() { return (unsigned)__builtin_amdgcn_s_getreg((3 << 11) | 20) & 0xFu; }
#define XB_SPIN(cond, bar) do { unsigned _sp = 0; while (cond) { __builtin_amdgcn_s_sleep(1); \
    if ((++_sp & 255u) == 0u) { if (xb_ld(&(bar)[XB_TMO])) break; if (_sp > XB_SPIN_CAP) { atomicAdd(&(bar)[XB_TMO], 1u); break; } } } } while (0)

struct XcdBarrier {
    unsigned* bar; unsigned x;
    volatile LAS unsigned* st;
};

__device__ __forceinline__ XcdBarrier xcd_barrier_post(unsigned* bar, volatile LAS unsigned* st) {
    XcdBarrier b; b.bar = bar; b.x = xb_xcc_id(); b.st = st;
    if (threadIdx.x == 0) (void)xb_add(&bar[XB_XCNT(b.x)], 1u);
    return b;
}
__device__ __forceinline__ void xcd_barrier_complete(unsigned* bar, unsigned x, unsigned& nloc, unsigned& nx) {
    const unsigned G = gridDim.x * gridDim.y * gridDim.z;
    unsigned sum, cnt, mine, sp = 0u;
    for (;;) {
        sum = 0u; cnt = 0u; mine = 0u;
#pragma unroll
        for (unsigned j = 0; j < 16; ++j) { const unsigned c = xb_ld(&bar[XB_XCNT(j)]); sum += c; cnt += (c > 0u) ? 1u : 0u; mine = (j == x) ? c : mine; }
        if (sum == G) break;
        __builtin_amdgcn_s_sleep(1);
        if ((++sp & 255u) == 0u) { if (xb_ld(&bar[XB_TMO])) break; if (sp > XB_SPIN_CAP) { atomicAdd(&bar[XB_TMO], 1u); break; } }
    }
    nloc = mine > 0u ? mine : 1u; nx = cnt > 0u ? cnt : 1u;
}

__device__ __forceinline__ void xcd_barrier(const XcdBarrier& b) {
    asm volatile("s_waitcnt vmcnt(0)" ::: "memory");
    __syncthreads();
    if (threadIdx.x == 0) {
        unsigned* bar = b.bar;
        __builtin_amdgcn_s_waitcnt(0);
        unsigned nloc = b.st[0], nx = b.st[1];
        if (nloc == 0u) { xcd_barrier_complete(bar, b.x, nloc, nx); b.st[0] = nloc; b.st[1] = nx; }
        const unsigned old = xb_add(&bar[XB_XSUB(b.x)], 1u);
        const unsigned gen = old / nloc;
        if (old + 1u == (gen + 1u) * nloc) {
            __builtin_amdgcn_fence(__ATOMIC_RELEASE, "agent");
            asm volatile("s_waitcnt vmcnt(0)" ::: "memory");
            const unsigned og = xb_add(&bar[XB_TOP], 1u);
            const unsigned tg = og / nx;
            if (og + 1u == (tg + 1u) * nx) xb_add(&bar[XB_TOPGEN], 1u);
            else XB_SPIN(xb_ld(&bar[XB_TOPGEN]) == tg, bar);
            __builtin_amdgcn_fence(__ATOMIC_ACQUIRE, "agent");
            xb_add(&bar[XB_XGEN(b.x)], 1u);
            asm volatile("s_waitcnt vmcnt(0)" ::: "memory");
        } else {
            XB_SPIN(xb_ld(&bar[XB_XGEN(b.x)]) == gen, bar);
            __builtin_amdgcn_fence(__ATOMIC_ACQUIRE, "agent");
            asm volatile("s_waitcnt vmcnt(0)" ::: "memory");
        }
    }
    __syncthreads();
}
namespace att {
typedef unsigned short bf16;
typedef short bf16x8 __attribute__((ext_vector_type(8)));
typedef _Float16 f16x8 __attribute__((ext_vector_type(8)));
typedef _Float16 f16x2 __attribute__((ext_vector_type(2)));
typedef float f32x2v __attribute__((ext_vector_type(2)));
typedef short s16x4 __attribute__((ext_vector_type(4)));
typedef float f32x16 __attribute__((ext_vector_type(16)));
typedef float f32x4 __attribute__((ext_vector_type(4)));
typedef unsigned u32x4 __attribute__((ext_vector_type(4)));
constexpr int D = 128, PITCH = 6144, SEQ_ = 2048;
constexpr int NW = 8, QBLK = 32, KVBLK = 64, QB = NW * QBLK;
constexpr int SHM_V = KVBLK * D * 2, SHM_K = KVBLK * D * 2;
constexpr int QROWB = 272, QWAVEB = QBLK * QROWB;
constexpr int OFF_WS = 2 * SHM_V + 2 * SHM_K, OFF_BIAS = OFF_WS + NW * 64 * 4, OFF_Q = OFF_BIAS + SEQ_ * 4, LDS_BYTES = OFF_Q + NW * QWAVEB;
constexpr float THR2 = 8.f * 1.4426950408889634f;
constexpr float L2E = 1.4426950408889634f;

#define KSWZ(row, colB) ((row) * 256 + ((colB) ^ (((row) & 7) << 4)))
#define SBAR() __builtin_amdgcn_sched_barrier(0)
__device__ __forceinline__ int v_st(int k, int c) { const int kk = (k & ~0xC) | ((k & 4) << 1) | ((k & 8) >> 1); return ((kk >> 3) * 4 + (c >> 5)) * 512 + ((kk & 7) * 32 + (c & 31)) * 2; }
__device__ __forceinline__ int v_rd_base(int lane) { return ((lane & 3) << 3) | (((lane >> 2) & 3) << 6) | (((lane >> 4) & 1) << 5) | (((lane >> 5) & 1) << 8); }
constexpr int v_rd_off(int d0, int ks, int half) { return d0 * 512 + ks * 4096 + half * 2048; }
__device__ __forceinline__ int crow(int r, int hi) { return (r & 3) + 8 * (r >> 2) + 4 * hi; }
__device__ __forceinline__ unsigned cvtpk(float lo, float hi) { unsigned r; asm volatile("v_cvt_pk_bf16_f32 %0, %1, %2" : "=v"(r) : "v"(lo), "v"(hi)); return r; }
__device__ __forceinline__ bf16x8 load8(const bf16* p) { return *reinterpret_cast<const bf16x8*>(p); }
__device__ __forceinline__ bf16x8 ld16u(const bf16* ubase, unsigned voff) { return *reinterpret_cast<const bf16x8*>((const char*)ubase + (size_t)voff); }

__device__ __forceinline__ void mask_tile(f32x16& p0, f32x16& p1, int dq) {
    const float NEG = -__builtin_inff();
#pragma unroll
    for (int r = 0; r < 16; ++r) { const int c = (r & 3) + 8 * (r >> 2); if (dq - c < 0) p0[r] = NEG; if (dq - c - 32 < 0) p1[r] = NEG; }
}
__device__ __forceinline__ void partialSM(f32x16& p0, f32x16& p1, float& m_reg, float& mn, float& alpha) {
    float pmax = p0[0];
#pragma unroll
    for (int r = 1; r < 16; ++r) pmax = fmaxf(pmax, p0[r]);
#pragma unroll
    for (int r = 0; r < 16; ++r) pmax = fmaxf(pmax, p1[r]);
    { auto rr = __builtin_amdgcn_permlane32_swap(__float_as_uint(pmax), __float_as_uint(pmax), false, false);
      pmax = fmaxf(__uint_as_float(rr[0]), __uint_as_float(rr[1])); }
    if (__builtin_expect(__all((pmax - m_reg) <= THR2), 1)) { mn = m_reg; alpha = 1.f; }
    else { mn = fmaxf(m_reg, pmax); alpha = __builtin_amdgcn_exp2f(m_reg - mn); m_reg = mn; }
#pragma unroll
    for (int r = 0; r < 16; ++r) p0[r] = p0[r] - mn;
#pragma unroll
    for (int r = 0; r < 16; ++r) p1[r] = p1[r] - mn;
#pragma unroll
    for (int r = 0; r < 16; ++r) p0[r] = __builtin_amdgcn_exp2f(p0[r]);
}
#define PK4(P, B_, OUT) do { unsigned a0 = cvtpk(P[B_+0], P[B_+1]), a1 = cvtpk(P[B_+2], P[B_+3]);                          \
        unsigned b0 = cvtpk(P[B_+4], P[B_+5]), b1 = cvtpk(P[B_+6], P[B_+7]);                                             \
        auto r0 = __builtin_amdgcn_permlane32_swap(a0, b0, false, false); auto r1 = __builtin_amdgcn_permlane32_swap(a1, b1, false, false); \
        u32x4 w = {r0[0], r1[0], r0[1], r1[1]}; OUT = *reinterpret_cast<bf16x8*>(&w); } while (0)
__device__ __forceinline__ void finishSM(f32x16& p0, f32x16& p1, float alpha, float& l_reg, bf16x8& pa0, bf16x8& pa1, bf16x8& pa2, bf16x8& pa3) {
#pragma unroll
    for (int r = 0; r < 16; ++r) p1[r] = __builtin_amdgcn_exp2f(p1[r]);
    float ps = 0;
#pragma unroll
    for (int r = 0; r < 16; ++r) ps += p0[r];
#pragma unroll
    for (int r = 0; r < 16; ++r) ps += p1[r];
    { auto rr = __builtin_amdgcn_permlane32_swap(__float_as_uint(ps), __float_as_uint(ps), false, false);
      ps = __uint_as_float(rr[0]) + __uint_as_float(rr[1]); }
    l_reg = l_reg * alpha + ps;
    PK4(p0, 0, pa0); PK4(p0, 8, pa1); PK4(p1, 0, pa2); PK4(p1, 8, pa3);
}
__device__ __forceinline__ void sb_block32(f32x16& X, float& carry, int dqm, bool masked, const f16x8 A0, const f16x8 A1) {
    float L[16];
#pragma unroll
    for (int r = 0; r < 16; ++r) { const float z = X[r];
        const float e = __builtin_amdgcn_exp2f(-__builtin_fabsf(z));
        const float l2 = __builtin_amdgcn_logf(1.0f + e);
        float sp = fmaxf(z, 0.f) + l2;
        float lb = (z - sp) - carry;
        if (masked) { const int c = (r & 3) + 8 * (r >> 2); if (dqm - c < 0) { sp = 0.f; lb = -__builtin_inff(); } }
        L[r] = sp; X[r] = lb; }
    f16x8 b0, b1;
#pragma unroll
    for (int j = 0; j < 8; ++j) { b0[j] = (_Float16)L[j]; b1[j] = (_Float16)L[8 + j]; }
    f32x16 Y = __builtin_amdgcn_mfma_f32_32x32x16_f16(A0, b0, f32x16{}, 0, 0, 0);
    Y = __builtin_amdgcn_mfma_f32_32x32x16_f16(A1, b1, Y, 0, 0, 0);
#pragma unroll
    for (int r = 0; r < 16; ++r) X[r] = X[r] - Y[r];
    const float tot = Y[0] + L[0];
    auto rr = __builtin_amdgcn_permlane32_swap(__float_as_uint(tot), __float_as_uint(tot), false, false);
    carry += __uint_as_float(rr[0]);
}
__device__ __forceinline__ void partialSB(f32x16& p0, f32x16& p1, float& carry, int dq, bool masked, const f16x8 A0, const f16x8 A1) {
    sb_block32(p1, carry, dq - 1 - 32, masked, A0, A1);
    sb_block32(p0, carry, dq - 1, masked, A0, A1);
}
__device__ __forceinline__ void finishSB(f32x16& p0, f32x16& p1, bf16x8& pa0, bf16x8& pa1, bf16x8& pa2, bf16x8& pa3) {
#pragma unroll
    for (int r = 0; r < 16; ++r) p0[r] = __builtin_amdgcn_exp2f(p0[r]);
#pragma unroll
    for (int r = 0; r < 16; ++r) p1[r] = __builtin_amdgcn_exp2f(p1[r]);
    PK4(p0, 0, pa0); PK4(p0, 8, pa1); PK4(p1, 0, pa2); PK4(p1, 8, pa3);
}
template <int KB, bool BIAS>
__device__ __forceinline__ void qkt(f32x16& p0, f32x16& p1, const char* K_lds, int r32, int hi, const char* qbase, const float* bl) {
    if (BIAS) {
#pragma unroll
        for (int g = 0; g < 4; ++g) { const f32x4 a = *reinterpret_cast<const f32x4*>(bl + 8 * g + 4 * hi), b = *reinterpret_cast<const f32x4*>(bl + 32 + 8 * g + 4 * hi);
            p0[4 * g] = a[0]; p0[4 * g + 1] = a[1]; p0[4 * g + 2] = a[2]; p0[4 * g + 3] = a[3];
            p1[4 * g] = b[0]; p1[4 * g + 1] = b[1]; p1[4 * g + 2] = b[2]; p1[4 * g + 3] = b[3]; }
    } else { p0 = f32x16{}; p1 = f32x16{}; }
    const char* kb[4];
#pragma unroll
    for (int dd = 0; dd < 4; ++dd) kb[dd] = K_lds + KB * SHM_K + KSWZ(r32, (dd * 16 + hi * 8) * 2);
#pragma unroll
    for (int d0 = 0; d0 < 8; ++d0) { const char* a = kb[d0 & 3] + (d0 >> 2) * 128;
        bf16x8 b0 = *reinterpret_cast<const bf16x8*>(a);
        bf16x8 b1 = *reinterpret_cast<const bf16x8*>(a + 32 * 256);
        const bf16x8 qf = *reinterpret_cast<const bf16x8*>(qbase + d0 * 32);
        p0 = __builtin_amdgcn_mfma_f32_32x32x16_bf16(b0, qf, p0, 0, 0, 0);
        p1 = __builtin_amdgcn_mfma_f32_32x32x16_bf16(b1, qf, p1, 0, 0, 0); }
}
template <int VB>
__device__ __forceinline__ void pv_tile(f32x16* o, int vb0, bf16x8 pa0, bf16x8 pa1, bf16x8 pa2, bf16x8 pa3) {
#define TRRD(dst, off) asm volatile("ds_read_b64_tr_b16 %0, %1 offset:%2" : "=&v"(dst) : "v"(vb0), "i"(off) : "memory")
#define PV_D0(d0) do { s16x4 l0, l1, l2, l3, h0, h1, h2, h3; constexpr int b_ = VB * SHM_V + v_rd_off(d0, 0, 0); \
        TRRD(l0, b_); TRRD(h0, b_ + 2048); TRRD(l1, b_ + 4096); TRRD(h1, b_ + 6144); TRRD(l2, b_ + 8192); TRRD(h2, b_ + 10240); TRRD(l3, b_ + 12288); TRRD(h3, b_ + 14336); \
        asm volatile("s_waitcnt lgkmcnt(0)" ::: "memory"); SBAR();   \
        o[d0] = __builtin_amdgcn_mfma_f32_32x32x16_bf16(pa0, (bf16x8){l0[0], l0[1], l0[2], l0[3], h0[0], h0[1], h0[2], h0[3]}, o[d0], 0, 0, 0);   \
        o[d0] = __builtin_amdgcn_mfma_f32_32x32x16_bf16(pa1, (bf16x8){l1[0], l1[1], l1[2], l1[3], h1[0], h1[1], h1[2], h1[3]}, o[d0], 0, 0, 0);   \
        o[d0] = __builtin_amdgcn_mfma_f32_32x32x16_bf16(pa2, (bf16x8){l2[0], l2[1], l2[2], l2[3], h2[0], h2[1], h2[2], h2[3]}, o[d0], 0, 0, 0);   \
        o[d0] = __builtin_amdgcn_mfma_f32_32x32x16_bf16(pa3, (bf16x8){l3[0], l3[1], l3[2], l3[3], h3[0], h3[1], h3[2], h3[3]}, o[d0], 0, 0, 0); } while (0)
    PV_D0(0); PV_D0(1); PV_D0(2); PV_D0(3);
#undef PV_D0
#undef TRRD
}

struct BlockRef { const bf16* Q; const bf16* K; const bf16* V; bf16* O; int P0; };
struct Seam { bf16x8 st_v0, st_v1, st_k0, st_k1; };
#define VMW() asm volatile("s_waitcnt vmcnt(0)" ::: "memory")
#define VMWN(n) asm volatile("s_waitcnt vmcnt(%0)" :: "i"(n) : "memory")
#define SLOAD_H(Kp, Vp, k0) do { const bf16* kb_u = (Kp) + (size_t)(k0) * PITCH; const bf16* vb_u = (Vp) + (size_t)(k0) * PITCH;                  \
                         S.st_v0 = ld16u(vb_u, svoff); S.st_v1 = ld16u(vb_u + 32 * PITCH, svoff);              \
                         S.st_k0 = ld16u(kb_u, svoff); S.st_k1 = ld16u(kb_u + 32 * PITCH, svoff); } while (0)
#define SWRITE_HK(bf) do { *(bf16x8*)(K_lds + (bf) * SHM_K + kws) = S.st_k0; *(bf16x8*)(K_lds + (bf) * SHM_K + kws + 32 * 256) = S.st_k1; } while (0)
#define SWRITE_HV(bf) do { *(bf16x8*)(V_lds + (bf) * SHM_V + vst0) = S.st_v0; *(bf16x8*)(V_lds + (bf) * SHM_V + vst0 + vst1d) = S.st_v1; } while (0)
#define SWRITE_H(bf) do { SWRITE_HV(bf); SWRITE_HK(bf); } while (0)
template <bool SB> __device__ __forceinline__ int first_kb(int P0) { return SB ? (P0 / KVBLK + 3) * KVBLK : 0; }
__device__ __forceinline__ void build_bias(const float* logf, char* lds) {
    const int tid = threadIdx.x, lane = tid & 63, wid = tid >> 6; float* bl = (float*)(lds + OFF_BIAS); float* part = (float*)(lds + OFF_WS);
    const f32x4 c = *reinterpret_cast<const f32x4*>(logf + 4 * tid);
    float v0 = c[0], v1 = v0 + c[1], v2 = v1 + c[2], v3 = v2 + c[3];
    float inc = v3;
#pragma unroll
    for (int o = 1; o < 64; o <<= 1) { const float t = __shfl_up(inc, o); if (lane >= o) inc += t; }
    if (lane == 63) part[wid] = inc;
    __syncthreads();
    float woff = 0.f;
    for (int w = 0; w < wid; ++w) woff += part[w];
    const float off = woff + inc - v3;
    f32x4 o; o[0] = -(off + v0) * L2E; o[1] = -(off + v1) * L2E; o[2] = -(off + v2) * L2E; o[3] = -(off + v3) * L2E;
    *reinterpret_cast<f32x4*>(bl + 4 * tid) = o;
    __syncthreads();
}
template <bool SB>
__device__ __forceinline__ void attn_prime(const BlockRef& cur, char* lds, Seam& S) {
    const int tid = threadIdx.x, wid = __builtin_amdgcn_readfirstlane(tid >> 6), lane = tid & 63, r32 = lane & 31, hi = lane >> 5;
    const int sr = tid >> 4, sc = (tid & 15) * 8, kws = KSWZ(sr, sc * 2); char* K_lds = lds + 2 * SHM_V;
    const int kb0 = first_kb<SB>(cur.P0);
    const unsigned svoff = (unsigned)((sr * PITCH + sc) * 2), qvoff = (unsigned)((r32 * PITCH + hi * 8) * 2);
    { const bf16* qb_u = cur.Q + (size_t)(wid * QBLK) * PITCH; char* qbase = lds + OFF_Q + wid * QWAVEB + r32 * QROWB + hi * 16;
#pragma unroll
    for (int d0 = 0; d0 < 8; ++d0) *reinterpret_cast<bf16x8*>(qbase + d0 * 32) = ld16u(qb_u + d0 * 16, qvoff); }
    SLOAD_H(cur.K, cur.V, kb0); VMW(); SWRITE_HK(0);
    __syncthreads();
}
template <bool SB>
__device__ __forceinline__ void attn_block(const BlockRef& cur, const BlockRef& nxt, char* lds, Seam& S, const f16x8 A0, const f16x8 A1) {
    const int tid = threadIdx.x, wid = __builtin_amdgcn_readfirstlane(tid >> 6), lane = tid & 63, r32 = lane & 31, hi = lane >> 5;
    const int NT = cur.P0 / KVBLK + 4;
    const int kbn = first_kb<SB>(nxt.P0);
    const int qlo = cur.P0 + wid * QBLK, qm = qlo + r32 - 4 * hi;
    char* V_lds = lds; char* K_lds = lds + 2 * SHM_V;
    float* ws = (float*)(lds + OFF_WS) + wid * 64; float* li_l = ws, * al_l = ws + 32;
    const float* bl = (const float*)(lds + OFF_BIAS);
    float m_reg = -1e30f, l_reg = 0, carry = 0; f32x16 o[4] = {};
    const int sr = tid >> 4, sc = (tid & 15) * 8, vst0 = v_st(sr, sc), kws = KSWZ(sr, sc * 2); constexpr int vst1d = 8192;
    const int vb0 = (int)(uintptr_t)V_lds + v_rd_base(lane);
    const unsigned svoff = (unsigned)((sr * PITCH + sc) * 2);
    const bf16* Kh = cur.K; const bf16* Vh = cur.V;
    char* qbase = lds + OFF_Q + wid * QWAVEB + r32 * QROWB + hi * 16;
#define RESC(a) do { if (__any((a) < 1.f)) { if (hi == 0) al_l[r32] = (a); asm volatile("s_waitcnt lgkmcnt(0)" ::: "memory");              \
                     for (int d_ = 0; d_ < 4; ++d_) for (int r = 0; r < 16; ++r) o[d_][r] *= al_l[crow(r, hi)]; } } while (0)
#define KBASE(t) ((SB ? (NT - 1 - (t)) : (t)) * KVBLK)
#define NEEDM(t) (KBASE(t) + KVBLK - 1 > qlo - (SB ? 1 : 0))
#define QKT(KB, P0_, P1_, t) qkt<KB, !SB>(P0_, P1_, K_lds, r32, hi, qbase, bl + KBASE(t))
#define PART(P0_, P1_, mnX, alX, t) do { const int kb_ = KBASE(t); if constexpr (SB) { partialSB(P0_, P1_, carry, qm - kb_, NEEDM(t), A0, A1); } \
        else { if (NEEDM(t)) mask_tile(P0_, P1_, qm - kb_); partialSM(P0_, P1_, m_reg, mnX, alX); } } while (0)
#define FIN(P0_, P1_, alY) do { if constexpr (SB) finishSB(P0_, P1_, pa0, pa1, pa2, pa3); else finishSM(P0_, P1_, alY, l_reg, pa0, pa1, pa2, pa3); } while (0)
    constexpr int NQL = 0;
#define SEAM_K0() do { VMWN(NQL); SWRITE_HK(0); SBAR(); } while (0)
    f32x16 pA0, pA1, pB0, pB1; float mnA = 0, mnB = 0, alA = 1.f, alB = 1.f; bf16x8 pa0, pa1, pa2, pa3;
    SWRITE_HV(0); SBAR();
    SLOAD_H(Kh, Vh, KBASE(1));
    SBAR(); QKT(0, pA0, pA1, 0);
    PART(pA0, pA1, mnA, alA, 0);
    VMW(); SWRITE_H(1);
    __syncthreads();
#define HALF_STEP(PX0, PX1, mnX, alX, PY0, PY1, alY, t, KB, VB, SB_) do {                                                      \
        SBAR(); QKT(KB, PX0, PX1, t);                                                                                          \
        FIN(PY0, PY1, alY); SBAR();                                                                                            \
        if ((t) + 1 < NT) { SLOAD_H(Kh, Vh, KBASE((t) + 1)); SBAR(); }                                                         \
        pv_tile<VB>(o, vb0, pa0, pa1, pa2, pa3); PART(PX0, PX1, mnX, alX, t);                                                   \
        __syncthreads();                                                                                                       \
        if ((t) + 1 < NT) { VMW(); SWRITE_H(SB_); }                                                                            \
        if constexpr (!SB) RESC(alX);                                                                                          \
        __syncthreads(); } while (0)
    for (int t = 1; t + 1 < NT; t += 2) {
        HALF_STEP(pB0, pB1, mnB, alB, pA0, pA1, alA, t, 1, 0, 0);
        HALF_STEP(pA0, pA1, mnA, alA, pB0, pB1, alB, t + 1, 0, 1, 1);
    }
    SBAR(); QKT(1, pB0, pB1, NT - 1); SBAR();
    SLOAD_H(nxt.K, nxt.V, kbn); SBAR();
    FIN(pA0, pA1, alA); SBAR();
    pv_tile<0>(o, vb0, pa0, pa1, pa2, pa3);
    PART(pB0, pB1, mnB, alB, NT - 1); __syncthreads();
    if constexpr (!SB) RESC(alB);
    FIN(pB0, pB1, alB); SBAR(); pv_tile<1>(o, vb0, pa0, pa1, pa2, pa3);
    SBAR(); SEAM_K0();
    float rli[16];
    if constexpr (!SB) { if (hi == 0) li_l[r32] = l_reg; asm volatile("s_waitcnt lgkmcnt(0)" ::: "memory");
#pragma unroll
        for (int r = 0; r < 16; ++r) rli[r] = __builtin_amdgcn_rcpf(li_l[crow(r, hi)]); }
    else {
#pragma unroll
        for (int r = 0; r < 16; ++r) rli[r] = 1.f; }
    bf16* Ow = cur.O + (size_t)(wid * QBLK) * PITCH;
    int lane_e = lane; asm volatile("" : "+v"(lane_e));
    const int r32e = lane_e & 31, hie = lane_e >> 5;
    const unsigned ovoff = (unsigned)((4 * hie * PITCH + r32e) * 2), qvoff = (unsigned)((r32e * PITCH + hie * 8) * 2);
#pragma unroll
    for (int r = 0; r < 16; ++r) { const int orow0 = (r & 3) + 8 * (r >> 2);
#pragma unroll
        for (int d0 = 0; d0 < 4; ++d0) { const float v = o[d0][r] * rli[r];
            const float vn = __shfl_xor(v, 1);
            if ((r32e & 1) == 0) *(unsigned*)((char*)(Ow + (size_t)orow0 * PITCH + d0 * 32) + (size_t)ovoff) = cvtpk(v, vn); } }
    { const bf16* qb_u = nxt.Q + (size_t)(wid * QBLK) * PITCH;
#pragma unroll
    for (int d0 = 0; d0 < 8; ++d0) *reinterpret_cast<bf16x8*>(qbase + d0 * 32) = ld16u(qb_u + d0 * 16, qvoff); }
    __syncthreads();
#undef RESC
#undef KBASE
#undef NEEDM
#undef QKT
#undef PART
#undef FIN
#undef SEAM_K0
#undef HALF_STEP
}
#undef VMW
#undef VMWN
#undef SLOAD_H
#undef SWRITE_HK
#undef SWRITE_HV
#undef SWRITE_H
#undef PK4
#undef KSWZ
#undef SBAR

__device__ __forceinline__ void scan_consts(f16x8& A0, f16x8& A1) {
    const int lane = threadIdx.x & 63, i = lane & 31, h = lane >> 5;
#pragma unroll
    for (int j = 0; j < 8; ++j) { const int k0 = 8 * (j >> 2) + 4 * h + (j & 3), k1 = 16 + k0;
        A0[j] = (k0 > i) ? (_Float16)1.0f : (_Float16)0.0f; A1[j] = (k1 > i) ? (_Float16)1.0f : (_Float16)0.0f; }
}
__device__ __forceinline__ void attn_phase(char* lds, bf16* QKV, const float* LOGF, int v, int G) {
    for (int item = v; item < 256; item += G) {
        const int bh = item >> 2, p = item & 3, b = bh >> 3, h = bh & 7;
        bf16* base = QKV + (size_t)b * SEQ_ * PITCH;
#ifndef NO_SB
        { f16x8 A0, A1; scan_consts(A0, A1); Seam S; BlockRef c0, c1;
          c0.K = base + 2048 + h * D; c0.V = base + 3072 + h * D; c1 = c0;
          c0.P0 = (7 - p) * QB; c0.Q = base + (size_t)c0.P0 * PITCH + h * D; c0.O = (bf16*)c0.Q;
          c1.P0 = p * QB; c1.Q = base + (size_t)c1.P0 * PITCH + h * D; c1.O = (bf16*)c1.Q;
          attn_prime<true>(c0, lds, S); attn_block<true>(c0, c1, lds, S, A0, A1); attn_block<true>(c1, c1, lds, S, A0, A1); }
#endif
#ifndef NO_FOX
        { const f16x8 A0 = {}, A1 = {}; Seam S; BlockRef c0, c1;
          c0.K = base + 4096 + h * D; c0.V = base + 5120 + h * D; c1 = c0;
          c0.P0 = (7 - p) * QB; c0.Q = base + (size_t)c0.P0 * PITCH + 1024 + h * D; c0.O = (bf16*)c0.Q;
          c1.P0 = p * QB; c1.Q = base + (size_t)c1.P0 * PITCH + 1024 + h * D; c1.O = (bf16*)c1.Q;
          build_bias(LOGF + (size_t)bh * SEQ_, lds);
          attn_prime<false>(c0, lds, S); attn_block<false>(c0, c1, lds, S, A0, A1); attn_block<false>(c1, c1, lds, S, A0, A1); }
#endif
    }
}
}
struct Frame {
    LAS unsigned char* lds;
    volatile LAS unsigned* MISC;
    gu32* ctl;
    int tid, lane, wave;
    int vcu, G;
    const float* x; float* out;
    const float *g_mix_pre, *g_mix_post, *w_in, *b_forget, *w_bsb, *w_bfx, *w_out, *g_ffn_pre, *g_ffn_post, *w_gate, *w_up, *w_down;
    bf16 *Win_t, *Wbr_t, *Wout_t, *Wgu_t, *Wdn_t;
    bf16 *U, *QKV, *GT, *HDN, *MIX, *FFO;
    float *LOGF;
};

__device__ __forceinline__ float wave_sum(float v) {
#pragma unroll
    for (int o = 1; o < 64; o <<= 1) v += __shfl_xor(v, o);
    return v;
}
__device__ __forceinline__ unsigned cvtpk_bf16(float lo, float hi) { unsigned r; asm volatile("v_cvt_pk_bf16_f32 %0, %1, %2" : "=v"(r) : "v"(lo), "v"(hi)); return r; }
__device__ __forceinline__ void tr_item(const float* W, int Npitch, int ncol0, bf16* WT, int dpitch, int drow0, int dk0, LAS unsigned char* scr, int kb, int lane) {
    const int k0 = 64 * kb, kp = lane >> 3, nc = lane & 7;
    const float* src = W + (size_t)(k0 + 2 * kp) * Npitch + ncol0 + 4 * nc;
    f32x4 a[4], b[4];
#pragma unroll
    for (int i = 0; i < 4; ++i) { a[i] = *(const GAS f32x4*)(src + (size_t)(16 * i) * Npitch); b[i] = *(const GAS f32x4*)(src + (size_t)(16 * i + 1) * Npitch); }
#pragma unroll
    for (int i = 0; i < 4; ++i) {
        LAS unsigned char* t = scr + (4 * nc) * 144 + (16 * i + 2 * kp) * 2;
        *(LAS unsigned*)(t) = cvtpk_bf16(a[i].x, b[i].x); *(LAS unsigned*)(t + 144) = cvtpk_bf16(a[i].y, b[i].y);
        *(LAS unsigned*)(t + 288) = cvtpk_bf16(a[i].z, b[i].z); *(LAS unsigned*)(t + 432) = cvtpk_bf16(a[i].w, b[i].w); }
    LDS_WAIT(); asm volatile("" ::: "memory");
#pragma unroll
    for (int j = 0; j < 4; ++j) { const int n = 8 * j + (lane >> 3), kc = lane & 7;
        const v4u o = *(const LAS v4u*)(scr + n * 144 + kc * 16);
        *(GAS v4u*)(WT + (size_t)(drow0 + n) * dpitch + dk0 + k0 + 8 * kc) = o; }
    LDS_WAIT(); asm volatile("" ::: "memory");
}
struct Seg { const float* W; int K, Npitch, n0, ncols; bf16* WT; int dpitch, drow0, dk0, rowmode; };
__device__ __forceinline__ int seg_items(const Seg& s) { return (s.K / 64) * (s.ncols / 32); }
__device__ __forceinline__ void seg_item(const Seg& s, int item, LAS unsigned char* scr, int lane) {
    const int nblk = s.ncols / 32, kb = item / nblk, nb = item % nblk, n = 32 * nb;
    int drow = s.drow0 + n;
    if (s.rowmode) drow = 256 * (n >> 7) + (n & 127) + (s.rowmode == 2 ? 128 : 0);
    tr_item(s.W, s.Npitch, s.n0 + n, s.WT, s.dpitch, drow, s.dk0, scr, kb, lane);
}

__device__ __forceinline__ void p0_prologue(Frame& F) {
    LAS unsigned char* scr = F.lds + RING_OFF + F.wave * 16384;
    const int gw = F.vcu * NWAVES + F.wave, NGW = F.G * NWAVES;
    {
        const Seg segs[11] = {
            {F.w_in, DM, DIN, 0, 1024, F.Win_t, DM, 0, 0, 0},
            {F.w_in, DM, DIN, 1024, 2048, F.Win_t, DM, 2048, 0, 0},
            {F.w_in, DM, DIN, 3072, 1024, F.Win_t, DM, 1024, 0, 0},
            {F.w_in, DM, DIN, 4096, 2048, F.Win_t, DM, 4096, 0, 0},
            {F.w_in, DM, DIN, 6152, 4096, F.Win_t, DM, 6144, 0, 0},
            {F.w_bsb, DSB, DM, 0, DM, F.Wbr_t, 2 * DSB, 0, 0, 0},
            {F.w_bfx, DSB, DM, 0, DM, F.Wbr_t, 2 * DSB, 0, DSB, 0},
            {F.w_out, DM, DM, 0, DM, F.Wout_t, DM, 0, 0, 0},
            {F.w_gate, DM, FF, 0, FF, F.Wgu_t, DM, 0, 0, 1},
            {F.w_up, DM, FF, 0, FF, F.Wgu_t, DM, 0, 0, 2},
            {F.w_down, FF, DM, 0, DM, F.Wdn_t, FF, 0, 0, 0},
        };
        int base = 0;
#pragma unroll
        for (int si = 0; si < 11; ++si) {
            const int ni = seg_items(segs[si]);
            int first = (gw - (base % NGW) + NGW) % NGW;
            for (int it = first; it < ni; it += NGW) seg_item(segs[si], it, scr, F.lane);
            base += ni;
        }
    }
    __syncthreads();
    LAS float* Wf = (LAS float*)(F.lds + RING_OFF);
    for (int k = F.tid; k < DM; k += NWAVES * 64) {
        const float g = F.g_mix_pre[k];
        const f32x4 a = *(const GAS f32x4*)(F.w_in + (size_t)k * DIN + 6144), b = *(const GAS f32x4*)(F.w_in + (size_t)k * DIN + 6148);
        Wf[0 * DM + k] = g * a.x; Wf[1 * DM + k] = g * a.y; Wf[2 * DM + k] = g * a.z; Wf[3 * DM + k] = g * a.w;
        Wf[4 * DM + k] = g * b.x; Wf[5 * DM + k] = g * b.y; Wf[6 * DM + k] = g * b.z; Wf[7 * DM + k] = g * b.w;
    }
    __syncthreads();
    const float bfh = F.b_forget[F.lane & 7];
    for (int m = gw; m < M; m += NGW) {
        const GAS f32x4* xr = (const GAS f32x4*)(F.x + (size_t)m * DM) + F.lane;
        f32x4 v[8]; float s = 0.f;
#pragma unroll
        for (int j = 0; j < 8; ++j) { v[j] = xr[64 * j]; s += (v[j].x * v[j].x + v[j].y * v[j].y) + (v[j].z * v[j].z + v[j].w * v[j].w); }
        const float rstd = 1.0f / sqrtf(wave_sum(s) * (1.f / DM) + RMS_EPS);
        float fa[8];
#pragma unroll
        for (int h = 0; h < 8; ++h) { float a = 0.f;
#pragma unroll
            for (int j = 0; j < 8; ++j) { const f32x4 w = *(const LAS f32x4*)(Wf + h * DM + 256 * j + 4 * F.lane); a += (v[j].x * w.x + v[j].y * w.y) + (v[j].z * w.z + v[j].w * w.w); }
            fa[h] = a; asm volatile("" : "+v"(fa[h])); }
        float r4[4], r2[2], mine;
        { const bool up = (F.lane & 1) != 0;
#pragma unroll
          for (int q = 0; q < 4; ++q) { const float keep = up ? fa[2 * q + 1] : fa[2 * q], give = up ? fa[2 * q] : fa[2 * q + 1]; r4[q] = keep + __shfl_xor(give, 1); } }
        { const bool up = (F.lane & 2) != 0;
#pragma unroll
          for (int q = 0; q < 2; ++q) { const float keep = up ? r4[2 * q + 1] : r4[2 * q], give = up ? r4[2 * q] : r4[2 * q + 1]; r2[q] = keep + __shfl_xor(give, 2); } }
        { const bool up = (F.lane & 4) != 0; const float keep = up ? r2[1] : r2[0], give = up ? r2[0] : r2[1]; mine = keep + __shfl_xor(give, 4); }
        mine += __shfl_xor(mine, 8); mine += __shfl_xor(mine, 16); mine += __shfl_xor(mine, 32);
        GAS unsigned long long* o8 = (GAS unsigned long long*)(F.U + (size_t)m * DM) + F.lane;
#pragma unroll
        for (int j = 0; j < 8; ++j) { const f32x4 gj = ((const GAS f32x4*)F.g_mix_pre)[64 * j + F.lane]; const f32x4 u = v[j] * rstd * gj;
            o8[64 * j] = (unsigned long long)pk2(u.x, u.y) | ((unsigned long long)pk2(u.z, u.w) << 32); }
        if (F.lane < 8) { const float y = mine * rstd + bfh;
            F.LOGF[(size_t)((m / SEQ) * NH + F.lane) * SEQ + (m % SEQ)] = -(fmaxf(-y, 0.f) + log1pf(expf(-fabsf(y)))); }
    }
}

#if defined(NAIVE_ATTN)
__device__ __forceinline__ void unpack8(const v4u w, float* f) {
    f[0] = __uint_as_float(w.x << 16); f[1] = __uint_as_float(w.x & 0xffff0000u); f[2] = __uint_as_float(w.y << 16); f[3] = __uint_as_float(w.y & 0xffff0000u);
    f[4] = __uint_as_float(w.z << 16); f[5] = __uint_as_float(w.z & 0xffff0000u); f[6] = __uint_as_float(w.w << 16); f[7] = __uint_as_float(w.w & 0xffff0000u);
}
__device__ __forceinline__ void naive_attn_item(Frame& F, int br, int b, int h, int qb) {
    LAS bf16* Ks = (LAS bf16*)(F.lds + RING_OFF); LAS bf16* Vs = Ks + 64 * HD;
    const int row = F.tid >> 2, part = F.tid & 3, t = qb * 128 + row;
    const size_t grow = (size_t)(b * SEQ + t);
    const bf16* qp = F.QKV + grow * NQKV + (br ? COL_QFX : COL_QSB) + h * HD + part * 32;
    float q[32], o[32];
#pragma unroll
    for (int c = 0; c < 4; ++c) { unpack8(*(const GAS v4u*)(qp + 8 * c), q + 8 * c); }
#pragma unroll
    for (int i = 0; i < 32; ++i) o[i] = 0.f;
    const int kcol = (br ? COL_KFX : COL_KSB) + h * HD, vcol = (br ? COL_VFX : COL_VSB) + h * HD;
    const float* cum = F.CUM + (size_t)(b * NH + h) * SEQ;
    const float cq = br ? cum[t] * LOG2E : 0.f;
    float mrun = -1e30f, lrun = 0.f, carry = 0.f;
    const int NT = (qb * 128 + 128) / 64;
    for (int it = 0; it < NT; ++it) {
        const int jt = br ? it : NT - 1 - it;
        __syncthreads();
#pragma unroll
        for (int i = 0; i < 2; ++i) { const int idx = F.tid + 512 * i, r = idx >> 4, c = (idx & 15) * 8; const size_t gr = (size_t)(b * SEQ + jt * 64 + r) * NQKV;
            *(LAS v4u*)(Ks + r * HD + c) = *(const GAS v4u*)(F.QKV + gr + kcol + c); *(LAS v4u*)(Vs + r * HD + c) = *(const GAS v4u*)(F.QKV + gr + vcol + c); }
        __syncthreads();
        for (int kk = 0; kk < 64; ++kk) {
            const int si = br ? kk : 63 - kk, s = jt * 64 + si;
            float d = 0.f; float kf[8];
#pragma unroll
            for (int c = 0; c < 4; ++c) { unpack8(*(const LAS v4u*)(Ks + si * HD + part * 32 + 8 * c), kf);
#pragma unroll
                for (int e = 0; e < 8; ++e) d += q[8 * c + e] * kf[e]; }
            d += __shfl_xor(d, 1); d += __shfl_xor(d, 2);
            float wgt = 0.f, alpha = 1.f;
            if (br) {
                if (s <= t) { const float logit = d + cq - cum[s] * LOG2E; const float mn = fmaxf(mrun, logit);
                    alpha = exp2f(mrun - mn); wgt = exp2f(logit - mn); lrun = lrun * alpha + wgt; mrun = mn; }
            } else {
                if (s < t) { const float e = exp2f(-fabsf(d)); const float l2 = log2f(1.0f + e); const float sp = fmaxf(d, 0.f) + l2;
                    wgt = exp2f((d - sp) - carry); carry += sp; }
            }
#pragma unroll
            for (int c = 0; c < 4; ++c) { unpack8(*(const LAS v4u*)(Vs + si * HD + part * 32 + 8 * c), kf);
#pragma unroll
                for (int e = 0; e < 8; ++e) o[8 * c + e] = o[8 * c + e] * alpha + wgt * kf[e]; }
        }
    }
    const float inv = br ? 1.0f / lrun : 1.0f;
    bf16* op = F.QKV + grow * NQKV + (br ? 1024 : 0) + h * HD + part * 32;
#pragma unroll
    for (int c = 0; c < 4; ++c) { v4u w; w.x = pk2(o[8 * c] * inv, o[8 * c + 1] * inv); w.y = pk2(o[8 * c + 2] * inv, o[8 * c + 3] * inv);
        w.z = pk2(o[8 * c + 4] * inv, o[8 * c + 5] * inv); w.w = pk2(o[8 * c + 6] * inv, o[8 * c + 7] * inv); *(GAS v4u*)(op + 8 * c) = w; }
}
__device__ __forceinline__ void naive_attn_phase(Frame& F) {
    for (int i = blockIdx.x; i < 16 * 128; i += F.G) { const int qb = i >> 7, br = (i >> 6) & 1, bh = i & 63; naive_attn_item(F, br, bh / NH, bh % NH, qb); }
    __syncthreads();
}

#endif
__device__ __forceinline__ void unpack8f(const v4u w, f32x4& a, f32x4& b) {
    a.x = __uint_as_float(w.x << 16); a.y = __uint_as_float(w.x & 0xffff0000u); a.z = __uint_as_float(w.y << 16); a.w = __uint_as_float(w.y & 0xffff0000u);
    b.x = __uint_as_float(w.z << 16); b.y = __uint_as_float(w.z & 0xffff0000u); b.z = __uint_as_float(w.w << 16); b.w = __uint_as_float(w.w & 0xffff0000u);
}
__device__ __forceinline__ float sq4(const f32x4 v) { return (v.x * v.x + v.y * v.y) + (v.z * v.z + v.w * v.w); }
__device__ __forceinline__ void p5_rows(Frame& F) {
    const int gw = F.vcu * NWAVES + F.wave, NGW = F.G * NWAVES;
    for (int m = gw; m < M; m += NGW) {
        const GAS v4u* mr = (const GAS v4u*)(F.MIX + (size_t)m * DM);
        const GAS f32x4* xr = (const GAS f32x4*)(F.x + (size_t)m * DM);
        f32x4 v[8], xv[8]; float s = 0.f;
#pragma unroll
        for (int j = 0; j < 4; ++j) { const int c = 64 * j + F.lane; unpack8f(mr[c], v[2 * j], v[2 * j + 1]); xv[2 * j] = xr[2 * c]; xv[2 * j + 1] = xr[2 * c + 1]; s += sq4(v[2 * j]) + sq4(v[2 * j + 1]); }
        const float rstd = 1.0f / sqrtf(wave_sum(s) * (1.f / DM) + RMS_EPS);
        float s2 = 0.f;
        GAS f32x4* orow = (GAS f32x4*)(F.out + (size_t)m * DM);
#pragma unroll
        for (int j = 0; j < 4; ++j) { const int c = 64 * j + F.lane;
#pragma unroll
            for (int e = 0; e < 2; ++e) { const f32x4 g = ((const GAS f32x4*)F.g_mix_post)[2 * c + e]; const f32x4 hh = xv[2 * j + e] + v[2 * j + e] * rstd * g; v[2 * j + e] = hh; orow[2 * c + e] = hh; s2 += sq4(hh); } }
        const float rstd2 = 1.0f / sqrtf(wave_sum(s2) * (1.f / DM) + RMS_EPS);
        GAS v4u* o8 = (GAS v4u*)(F.U + (size_t)m * DM);
#pragma unroll
        for (int j = 0; j < 4; ++j) { const int c = 64 * j + F.lane; const f32x4 g0 = ((const GAS f32x4*)F.g_ffn_pre)[2 * c], g1 = ((const GAS f32x4*)F.g_ffn_pre)[2 * c + 1];
            const f32x4 a = v[2 * j] * rstd2 * g0, b = v[2 * j + 1] * rstd2 * g1; v4u w; w.x = pk2(a.x, a.y); w.y = pk2(a.z, a.w); w.z = pk2(b.x, b.y); w.w = pk2(b.z, b.w); o8[c] = w; }
    }
}
__device__ __forceinline__ void p8_rows(Frame& F) {
    const int gw = F.vcu * NWAVES + F.wave, NGW = F.G * NWAVES;
    for (int m = gw; m < M; m += NGW) {
        const GAS v4u* fr = (const GAS v4u*)(F.FFO + (size_t)m * DM);
        GAS f32x4* orow = (GAS f32x4*)(F.out + (size_t)m * DM);
        f32x4 v[8], hv[8]; float s = 0.f;
#pragma unroll
        for (int j = 0; j < 4; ++j) { const int c = 64 * j + F.lane; unpack8f(fr[c], v[2 * j], v[2 * j + 1]); hv[2 * j] = orow[2 * c]; hv[2 * j + 1] = orow[2 * c + 1]; s += sq4(v[2 * j]) + sq4(v[2 * j + 1]); }
        const float rstd = 1.0f / sqrtf(wave_sum(s) * (1.f / DM) + RMS_EPS);
#pragma unroll
        for (int j = 0; j < 4; ++j) { const int c = 64 * j + F.lane;
#pragma unroll
            for (int e = 0; e < 2; ++e) { const f32x4 g = ((const GAS f32x4*)F.g_ffn_post)[2 * c + e]; orow[2 * c + e] = hv[2 * j + e] + v[2 * j + e] * rstd * g; } }
    }
}

#ifndef SKEW_MASK
#define SKEW_MASK 0
#endif
#ifndef SKEW_SLEEP
#define SKEW_SLEEP 6
#endif
__device__ __forceinline__ void phase_skew(Frame& F) {
    const int j = F.vcu & 31;
    for (int i = 0; i < j; ++i) __builtin_amdgcn_s_sleep(SKEW_SLEEP);
}
__device__ __forceinline__ void ph1(Frame& F) {
    if (SKEW_MASK & 2) phase_skew(F);
    pg8::Gemm g{F.U, F.Win_t, M, NPROJ, DM, DM}; pg8::StaticOrder S; S.init(M, NPROJ, F.G, (int)blockIdx.x);
    pg8::EpiProj E{F.QKV, F.GT, NQKV, NGATE, NQKV / 256, 2048 / 256, QSCALE, 0};
    pg8::gemm_phase<pg8::EpiProj, pg8::StaticOrder, PG8_ALIGN, PG8_SP2>(F.lds + RING_OFF, g, S, E);
}
__device__ __forceinline__ void ph3(Frame& F) {
    pg8::Gemm g{F.QKV, F.Wbr_t, M, DM, 2 * DSB, NQKV}; pg8::StaticOrder S; S.init(M, DM, F.G, (int)blockIdx.x);
    pg8::EpiBranch E{F.U, F.GT, DM, NGATE, DM, DSB / 64};
    pg8::gemm_phase<pg8::EpiBranch, pg8::StaticOrder, PG8_ALIGN, PG8_SP2>(F.lds + RING_OFF, g, S, E);
}
__device__ __forceinline__ void ph4(Frame& F) {
    pg8::Gemm g{F.U, F.Wout_t, M, DM, DM, DM}; pg8::StaticOrder S; S.init(M, DM, F.G, (int)blockIdx.x);
    pg8::EpiBf16 E{F.MIX, DM, 0};
    pg8::gemm_phase<pg8::EpiBf16, pg8::StaticOrder, PG8_ALIGN, PG8_SP2>(F.lds + RING_OFF, g, S, E);
}
__device__ __forceinline__ void ph6(Frame& F) {
    if (SKEW_MASK & 64) phase_skew(F);
    pg8::Gemm g{F.U, F.Wgu_t, M, NGU, DM, DM}; pg8::StaticOrder S; S.init(M, NGU, F.G, (int)blockIdx.x);
    pg8::EpiSwiGLU E{F.HDN, FF, 0};
    pg8::gemm_phase<pg8::EpiSwiGLU, pg8::StaticOrder, PG8_ALIGN, PG8_SP2>(F.lds + RING_OFF, g, S, E);
}
__device__ __forceinline__ void ph7(Frame& F) {
    pg8::Gemm g{F.HDN, F.Wdn_t, M, DM, FF, FF}; pg8::StaticOrder S; S.init(M, DM, F.G, (int)blockIdx.x);
    pg8::EpiBf16 E{F.FFO, DM, 0};
    pg8::gemm_phase<pg8::EpiBf16, pg8::StaticOrder, PG8_ALIGN, PG8_SP2>(F.lds + RING_OFF, g, S, E);
}

struct Args { const float* in[13]; float* out; unsigned char* ws; int ph_lo, ph_hi; };
__global__ void __launch_bounds__(NWAVES * 64, 2) layer_fwd(Args args) {
    extern __shared__ __attribute__((aligned(16))) unsigned char lds[];
    Frame F;
    F.lds = (LAS unsigned char*)lds;
    F.MISC = (volatile LAS unsigned*)(F.lds + MISC_OFF);
    F.tid = threadIdx.x; F.lane = F.tid & 63; F.wave = __builtin_amdgcn_readfirstlane(F.tid >> 6);
    F.G = gridDim.x; { const int bx = blockIdx.x; F.vcu = (F.G % 8 == 0) ? (bx % 8) * (F.G / 8) + bx / 8 : bx; }
    unsigned char* ws = args.ws;
    F.ctl = (gu32*)(ws + WS_CTL);
    F.x = args.in[0]; F.g_mix_pre = args.in[1]; F.g_mix_post = args.in[2]; F.w_in = args.in[3]; F.b_forget = args.in[4]; F.w_bsb = args.in[5]; F.w_bfx = args.in[6];
    F.w_out = args.in[7]; F.g_ffn_pre = args.in[8]; F.g_ffn_post = args.in[9]; F.w_gate = args.in[10]; F.w_up = args.in[11]; F.w_down = args.in[12]; F.out = args.out;
    F.Win_t = (bf16*)(ws + WS_WIN); F.Wbr_t = (bf16*)(ws + WS_WBR); F.Wout_t = (bf16*)(ws + WS_WOUT); F.Wgu_t = (bf16*)(ws + WS_WGU); F.Wdn_t = (bf16*)(ws + WS_WDN);
    F.U = (bf16*)(ws + WS_U); F.QKV = (bf16*)(ws + WS_QKV); F.GT = (bf16*)(ws + WS_G); F.HDN = (bf16*)(ws + WS_HDN);
    F.MIX = (bf16*)(ws + WS_MIX); F.FFO = (bf16*)(ws + WS_FFO); F.LOGF = (float*)(ws + WS_LOGF);
    for (int u = F.tid; u < (LDS_BYTES - LDSCTL_OFF) / 4; u += NWAVES * 64) ((LAS unsigned*)(F.lds + LDSCTL_OFF))[u] = 0u;
    __syncthreads();
    XcdBarrier bar; bar.bar = (unsigned*)(F.ctl + CW_BAR); bar.x = 0; bar.st = nullptr;
    if (N_LAUNCHES == 1) bar = xcd_barrier_post((unsigned*)(F.ctl + CW_BAR), F.MISC + 8);
#define GRID_BAR() do { if (N_LAUNCHES == 1) xcd_barrier(bar); } while (0)
    const int lo = args.ph_lo, hi = args.ph_hi;
#ifndef PH_MASK
#define PH_MASK 0x1ff
#endif
#define IN(k) (((PH_MASK >> (k)) & 1) && lo <= (k) && (k) < hi)
#define BOTH(k) (IN(k) && IN((k) + 1))
#ifndef REP_MASK
#define REP_MASK 0
#endif
#define REPQ(k) ((REP_MASK >> (k)) & 1)

    if (IN(0)) { p0_prologue(F); if (REPQ(0)) { __syncthreads(); p0_prologue(F); } if (BOTH(0)) GRID_BAR(); }
    if (IN(1)) { ph1(F); if (REPQ(1)) ph1(F); if (BOTH(1)) GRID_BAR(); }
#if defined(NAIVE_ATTN)
    if (IN(2)) { naive_attn_phase(F); if (BOTH(2)) GRID_BAR(); }
#else
    if (IN(2)) { att::attn_phase((char*)lds + RING_OFF, F.QKV, F.LOGF, F.vcu, F.G); if (BOTH(2)) GRID_BAR(); }
#endif
    if (IN(3)) { ph3(F); if (REPQ(3)) ph3(F); if (BOTH(3)) GRID_BAR(); }
    if (IN(4)) { ph4(F); if (REPQ(4)) ph4(F); if (BOTH(4)) GRID_BAR(); }
    if (IN(5)) { p5_rows(F); if (REPQ(5)) p5_rows(F); if (BOTH(5)) GRID_BAR(); }
    if (IN(6)) { ph6(F); if (REPQ(6)) ph6(F); if (BOTH(6)) GRID_BAR(); }
    if (IN(7)) { ph7(F); if (REPQ(7)) ph7(F); if (BOTH(7)) GRID_BAR(); }
    if (IN(8)) { p8_rows(F); }
#undef IN
#undef BOTH
}

extern "C" void kernel_launch(void* const* d_in, const int* in_sizes, int n_in, void* d_out, int out_size, void* d_ws, size_t ws_size, hipStream_t stream) {
    static int grid = 0;
    if (grid == 0) {
        if (n_in != 13 || in_sizes[0] != M * DM || out_size != M * DM || ws_size < WS_END) {
            fprintf(stderr, "kernel_launch: unexpected shapes (n_in %d, in0 %d, out %d, ws %zu); nothing launched\n", n_in, n_in > 0 ? in_sizes[0] : -1, out_size, ws_size); grid = -1; return; }
        int dev = 0, cus = 0, per_cu = 0;
        if (hipGetDevice(&dev) != hipSuccess || hipDeviceGetAttribute(&cus, hipDeviceAttributeMultiprocessorCount, dev) != hipSuccess) { grid = -1; return; }
        if (hipFuncSetAttribute((const void*)layer_fwd, hipFuncAttributeMaxDynamicSharedMemorySize, LDS_BYTES) != hipSuccess) { fprintf(stderr, "kernel_launch: hipFuncSetAttribute failed\n"); grid = -1; return; }
        if (hipOccupancyMaxActiveBlocksPerMultiprocessor(&per_cu, (const void*)layer_fwd, NWAVES * 64, LDS_BYTES) != hipSuccess || per_cu < 1)
            fprintf(stderr, "kernel_launch: note: occupancy query reports %d workgroups per CU\n", per_cu);
        (void)hipGetLastError();
        grid = cus;
    }
    if (grid < 0) return;
    if (hipMemsetAsync((char*)d_ws + WS_CTL, 0, CTL_ZERO_BYTES, stream) != hipSuccess) { fprintf(stderr, "kernel_launch: hipMemsetAsync failed\n"); return; }
    Args a{};
    for (int i = 0; i < 13; ++i) a.in[i] = (const float*)d_in[i];
    a.out = (float*)d_out; a.ws = (unsigned char*)d_ws;
    for (int li = 0; li < N_LAUNCHES; ++li) {
        a.ph_lo = (N_LAUNCHES == 1) ? 0 : li; a.ph_hi = (N_LAUNCHES == 1) ? N_PHASES : li + 1;
        hipLaunchKernelGGL(layer_fwd, dim3(grid), dim3(NWAVES * 64), LDS_BYTES, stream, a);
        const hipError_t le = hipPeekAtLastError();
        if (le != hipSuccess) { fprintf(stderr, "kernel_launch: launch %d failed: %s\n", li, hipGetErrorName(le)); break; }
    }
}
```
